# Optimizing an MI355X kernel written in HIP

```python
import math
import jax, jax.numpy as jnp
from jax import lax
import numpy as np

D_MODEL = 1024
BATCH = 16
SEQ = 2048
DEPTH = 1

N_META = 16
GRID_W = 64
CONV_DIM = 1024
CONV_K = 31
N_HEADS = 16
N_KV_HEADS = 4
HEAD_DIM = 64
GQA_GROUP = N_HEADS // N_KV_HEADS
ATTN_DIM = N_HEADS * HEAD_DIM
KV_DIM = N_KV_HEADS * HEAD_DIM
ROPE_FREQS = HEAD_DIM // 4
ROPE_THETA = 10000.0
Q_BLOCK = 128
NORM_EPS = 1e-6

IN_SPLITS = [CONV_DIM, CONV_DIM, CONV_DIM,
             ATTN_DIM, KV_DIM, KV_DIM, ATTN_DIM,
             D_MODEL, D_MODEL]
IN_DIM = sum(IN_SPLITS)
IN_OFFSETS = list(np.cumsum(IN_SPLITS)[:-1].tolist())

kernel_name = "hybrid_conformer_gqa_gated_encoder"


def rms_norm(x, g, eps=NORM_EPS):
    xf = x.astype(jnp.float32)
    y = xf * lax.rsqrt(jnp.mean(xf * xf, axis=-1, keepdims=True) + eps)
    return (y * g.astype(jnp.float32)).astype(x.dtype)


def layer_norm(x, g, b, eps=NORM_EPS):
    xf = x.astype(jnp.float32)
    mu = jnp.mean(xf, axis=-1, keepdims=True)
    xc = xf - mu
    y = xc * lax.rsqrt(jnp.mean(xc * xc, axis=-1, keepdims=True) + eps)
    return (y * g.astype(jnp.float32) + b.astype(jnp.float32)).astype(x.dtype)


def rope_tables(n_tok):
    rows = n_tok // GRID_W
    row_ids = jnp.concatenate([jnp.zeros((N_META,), jnp.float32),
                               jnp.repeat(jnp.arange(rows, dtype=jnp.float32), GRID_W)])
    col_ids = jnp.concatenate([jnp.zeros((N_META,), jnp.float32),
                               jnp.tile(jnp.arange(GRID_W, dtype=jnp.float32), rows)])
    inv_freq = ROPE_THETA ** (-jnp.arange(ROPE_FREQS, dtype=jnp.float32) / ROPE_FREQS)
    a_row = row_ids[:, None] * inv_freq[None, :]
    a_col = col_ids[:, None] * inv_freq[None, :]
    ang = jnp.concatenate([a_row, a_row, a_col, a_col], axis=-1)
    return jnp.cos(ang), jnp.sin(ang)


def apply_rope2d(x, cos, sin):
    xs = x.reshape(x.shape[:-1] + (2, 2, ROPE_FREQS))
    rot = jnp.stack([-xs[..., 1, :], xs[..., 0, :]], axis=-2).reshape(x.shape)
    c = cos[None, :, None, :].astype(x.dtype)
    s = sin[None, :, None, :].astype(x.dtype)
    return x * c + rot * s


def conv_branch(val, glu_gate, z, conv_w, conv_b, cn_g, cn_b, w_proj):
    u = val * jax.nn.sigmoid(glu_gate)
    kern = conv_w.reshape(CONV_K, 1, CONV_DIM).astype(u.dtype)
    pad = CONV_K // 2
    c = lax.conv_general_dilated(u, kern, window_strides=(1,), padding=[(pad, pad)],
                                 dimension_numbers=("NWC", "WIO", "NWC"),
                                 feature_group_count=CONV_DIM)
    c = c + conv_b.astype(c.dtype)
    c = jax.nn.silu(layer_norm(c, cn_g, cn_b))
    c = c * jax.nn.silu(z)
    return jnp.einsum("blc,cd->bld", c, w_proj.astype(c.dtype))


def attn_branch(q, k, v, z, q_g, k_g, w_proj, cos, sin):
    B, L, _ = q.shape
    n_tok = L - N_META
    q = q.reshape(B, L, N_HEADS, HEAD_DIM)
    k = k.reshape(B, L, N_KV_HEADS, HEAD_DIM)
    v = v.reshape(B, L, N_KV_HEADS, HEAD_DIM)
    q = apply_rope2d(rms_norm(q, q_g), cos, sin)
    k = apply_rope2d(rms_norm(k, k_g), cos, sin)
    q = q.reshape(B, L, N_KV_HEADS, GQA_GROUP, HEAD_DIM)
    scale = 1.0 / math.sqrt(HEAD_DIM)

    def attend(qb):
        s = jnp.einsum("bqkgd,bskd->bkgqs", qb, k).astype(jnp.float32) * scale
        p = jax.nn.softmax(s, axis=-1).astype(v.dtype)
        return jnp.einsum("bkgqs,bskd->bqkgd", p, v)

    o_meta = attend(q[:, :N_META])
    n_blk = n_tok // Q_BLOCK
    q_real = q[:, N_META:].reshape(B, n_blk, Q_BLOCK, N_KV_HEADS, GQA_GROUP, HEAD_DIM)
    o_real = lax.map(attend, jnp.moveaxis(q_real, 1, 0))
    o_real = jnp.moveaxis(o_real, 0, 1).reshape(B, n_tok, N_KV_HEADS, GQA_GROUP, HEAD_DIM)
    o = jnp.concatenate([o_meta, o_real], axis=1).reshape(B, L, ATTN_DIM)
    o = o * jax.nn.silu(z)
    return jnp.einsum("bla,ad->bld", o, w_proj.astype(o.dtype))


def hybrid_layer(h, norm_g, w_in, conv_w, conv_b, cn_g, cn_b, w_conv_out,
                 q_g, k_g, w_attn_out, w_out, cos, sin):
    xn = rms_norm(h, norm_g)
    proj = jnp.einsum("bld,de->ble", xn, w_in.astype(xn.dtype))
    (c_val, c_glu, c_z, q, k, v, a_z, g_c, g_a) = jnp.split(proj, IN_OFFSETS, axis=-1)
    y_c = conv_branch(c_val, c_glu, c_z, conv_w, conv_b, cn_g, cn_b, w_conv_out)
    y_a = attn_branch(q, k, v, a_z, q_g, k_g, w_attn_out, cos, sin)
    merged = jax.nn.sigmoid(g_c) * y_c + jax.nn.sigmoid(g_a) * y_a
    return jnp.einsum("bld,de->ble", merged, w_out.astype(merged.dtype))


def setup_inputs(seed: int = 0) -> dict:
    key = jax.random.key(seed)
    ks = jax.random.split(key, 16)
    f32 = jnp.float32
    nrm = lambda k, shape, s: jax.random.normal(k, shape, f32) * s
    return {
        "x": nrm(ks[0], (BATCH, SEQ, D_MODEL), 1.0),
        "meta_tokens": nrm(ks[1], (N_META, D_MODEL), 1.0),
        "norm_g": 1.0 + nrm(ks[2], (DEPTH, D_MODEL), 0.02),
        "w_in": nrm(ks[3], (DEPTH, D_MODEL, IN_DIM), D_MODEL ** -0.5),
        "conv_w": nrm(ks[4], (DEPTH, CONV_K, CONV_DIM), CONV_K ** -0.5),
        "conv_b": nrm(ks[5], (DEPTH, CONV_DIM), 0.02),
        "conv_norm_g": 1.0 + nrm(ks[6], (DEPTH, CONV_DIM), 0.02),
        "conv_norm_b": nrm(ks[7], (DEPTH, CONV_DIM), 0.02),
        "w_conv_out": nrm(ks[8], (DEPTH, CONV_DIM, D_MODEL), CONV_DIM ** -0.5),
        "q_norm_g": 1.0 + nrm(ks[9], (DEPTH, HEAD_DIM), 0.02),
        "k_norm_g": 1.0 + nrm(ks[10], (DEPTH, HEAD_DIM), 0.02),
        "w_attn_out": nrm(ks[11], (DEPTH, ATTN_DIM, D_MODEL), ATTN_DIM ** -0.5),
        "w_out": nrm(ks[12], (DEPTH, D_MODEL, D_MODEL), D_MODEL ** -0.5),
    }


def reference(x, meta_tokens, norm_g, w_in, conv_w, conv_b, conv_norm_g, conv_norm_b,
              w_conv_out, q_norm_g, k_norm_g, w_attn_out, w_out):
    B, n_tok, _ = x.shape
    meta = jnp.broadcast_to(meta_tokens[None].astype(x.dtype), (B, N_META, D_MODEL))
    h = jnp.concatenate([meta, x], axis=1)
    cos, sin = rope_tables(n_tok)
    for layer in range(DEPTH):
        h = h + hybrid_layer(h, norm_g[layer], w_in[layer], conv_w[layer], conv_b[layer],
                             conv_norm_g[layer], conv_norm_b[layer], w_conv_out[layer],
                             q_norm_g[layer], k_norm_g[layer], w_attn_out[layer],
                             w_out[layer], cos, sin)
    return h[:, N_META:]
```

```cpp
#include <hip/hip_runtime.h>
#include <cstdio>
#include <cstdint>
namespace pg8 {
#define PG8_LAS __attribute__((address_space(3)))
typedef unsigned short bf16_t;
typedef short bf16x8 __attribute__((ext_vector_type(8)));
typedef float f32x4 __attribute__((ext_vector_type(4)));
typedef unsigned u32x4 __attribute__((ext_vector_type(4)));
constexpr int BM = 256, BK = 64, HALF = 128, HTB = HALF * BK * 2  , STAGE_BYTES = 8 * HTB, NXCD = 8, WGM = 8;

__host__ __device__ __forceinline__ int lds_byte(int r, int c) { const int st = (r >> 4) * 2 + (c >> 5), rr = r & 15, cc = c & 31, ob = rr * 64 + cc * 2; return st * 1024 + (ob ^ (((ob >> 9) & 1) << 5)); }
__host__ __device__ __forceinline__ void stage_rc(int b, int& R, int& C) { const int st = b / 1024, sb = b % 1024, swz = sb ^ (((sb >> 9) & 1) << 5); R = (st >> 1) * 16 + swz / 64; C = (st & 1) * 32 + (swz % 64) / 2; }
__host__ __device__ __forceinline__ int perm32(int rho) { const int n = rho >> 4, i = rho & 15; return 8 * (i >> 2) + 4 * n + (i & 3); }

typedef int i32x4_t __attribute__((ext_vector_type(4))); typedef int i32x8_t __attribute__((ext_vector_type(8)));
constexpr int FP8_SCALE_A = 0x7f7f7f7f, FP8_SCALE_B = 0x79797979;
struct Unit { int pm, pn, kofs, pb; };
struct Gemm { const bf16_t* A; const bf16_t* Bt; int M, N, K, ld; };

struct StaticOrder {
    int nM, nN, nwg, G, c;
    __host__ __device__ void init(int M, int N, int G_, int c_) { nM = M / BM; nN = N / BM; nwg = nM * nN; G = G_; c = c_; }
    __host__ __device__ bool next(int i, Unit& u) const {
        const long L = (long)i * G + c; if (L >= nwg) return false;
        int wgid = (int)L; { const int q = nwg / NXCD, r = nwg % NXCD, xcd = wgid % NXCD, off = wgid / NXCD; wgid = (xcd < r ? xcd * (q + 1) : r * (q + 1) + (xcd - r) * q) + off; }
        const int nig = WGM * nN, gid = wgid / nig, fm = gid * WGM, gsz = (nM - fm) < WGM ? (nM - fm) : WGM;
        u.pm = fm + ((wgid % nig) % gsz); u.pn = (wgid % nig) / gsz; u.kofs = 0; u.pb = u.pn; return true;
    }
    __device__ __forceinline__ void a_ready(const Unit&) const {}
    __device__ __forceinline__ void done(const Unit&) const {}
};

typedef float f32x2c_t __attribute__((ext_vector_type(2))); typedef __bf16 bf16x2c_t __attribute__((ext_vector_type(2)));
__device__ __forceinline__ unsigned cvt_pk_bf16(float lo, float hi) { f32x2c_t v = {lo, hi}; bf16x2c_t b = __builtin_convertvector(v, bf16x2c_t); return __builtin_bit_cast(unsigned, b); }
typedef float f32x2 __attribute__((ext_vector_type(2)));
__device__ __forceinline__ f32x2 gelu_pk(f32x2 v) {
    const f32x2 av = __builtin_elementwise_abs(v), d = av * 0.2316418882f + 1.0f;
    f32x2 t; t.x = __builtin_amdgcn_rcpf(d.x); t.y = __builtin_amdgcn_rcpf(d.y);
    f32x2 q = t * 0.5307027145f + (-0.7265760135f); q = q * t + 0.7107068705f; q = q * t + (-0.142248368f); q = q * t + 0.127414796f; q = q * t;
    const f32x2 s = (v * v) * (-0.72134752044f);
    f32x2 e; e.x = __builtin_amdgcn_exp2f(s.x); e.y = __builtin_amdgcn_exp2f(s.y);
    const f32x2 m = v * (q * e), r = v - m;
    f32x2 o; o.x = v.x < 0.f ? m.x : r.x; o.y = v.y < 0.f ? m.y : r.y; return o;
}

template <int ACT  > struct EpiBf16 {
    static constexpr bool PERM = true, AFTER_DRAIN = false, HAS_MID = false; static_assert(ACT == 0 || ACT == 1, "EpiBf16: ACT is 0 (none) or 1 (gelu_pk)");
    bf16_t* O; int ldc; const float* bias; int split_cols; size_t split_stride; float scale0;
    __device__ __forceinline__ void operator()(const f32x4 (&acc)[2][2][4][2], const Unit& u, int wr, int wc, int fr, int fq) const {
        const int row0 = u.pm * BM + wr * 64 + fr; int colt = u.pn * BM; bf16_t* base = O;
        float sc = 1.f; if (split_cols) { const int t = colt / split_cols; base += (size_t)t * split_stride; colt -= t * split_cols; if (t == 0) sc = scale0; }
        const int col0 = colt + wc * 32 + 8 * fq, bcol0 = u.pn * BM + wc * 32 + 8 * fq;
        f32x4 bv[2][2];
#pragma unroll
        for (int bj = 0; bj < 2; ++bj)
#pragma unroll
            for (int n = 0; n < 2; ++n) bv[bj][n] = bias ? *(const f32x4*)(bias + bcol0 + bj * HALF + 4 * n) : (f32x4){0.f, 0.f, 0.f, 0.f};
#pragma unroll
        for (int ai = 0; ai < 2; ++ai)
#pragma unroll
            for (int m = 0; m < 4; ++m) { bf16_t* rowp = base + (size_t)(row0 + ai * HALF + m * 16) * ldc + col0;
#pragma unroll
                for (int bj = 0; bj < 2; ++bj) { f32x4 v0 = acc[ai][bj][m][0] + bv[bj][0], v1 = acc[ai][bj][m][1] + bv[bj][1];
                    if (ACT == 1) { f32x2 a = gelu_pk((f32x2){v0[0], v0[1]}), b = gelu_pk((f32x2){v0[2], v0[3]}), c = gelu_pk((f32x2){v1[0], v1[1]}), d = gelu_pk((f32x2){v1[2], v1[3]});
                        v0 = (f32x4){a.x, a.y, b.x, b.y}; v1 = (f32x4){c.x, c.y, d.x, d.y}; }
                    v0 = v0 * sc; v1 = v1 * sc; u32x4 w; w.x = cvt_pk_bf16(v0[0], v0[1]); w.y = cvt_pk_bf16(v0[2], v0[3]); w.z = cvt_pk_bf16(v1[0], v1[1]); w.w = cvt_pk_bf16(v1[2], v1[3]);
                    *(u32x4*)(rowp + bj * HALF) = w; } }
    }
};

struct RemapOrder {
    StaticOrder base; int mode;
    __host__ __device__ bool next(int i, Unit& u) const { if (!base.next(i, u)) return false; const int p = u.pn;
        if (mode == 0) { u.pn = p < 12 ? p : p + 10; u.pb = u.pn; } else { u.pn = p < 10 ? 12 + p : 16 + p; u.pb = p; } return true; }
    __device__ __forceinline__ void a_ready(const Unit&) const {}
    __device__ __forceinline__ void done(const Unit&) const {}
};
struct TwoPassOrder {
    StaticOrder base; int K;
    __host__ __device__ bool next(int i, Unit& u) const { if (!base.next(i >> 1, u)) return false; u.kofs = (i & 1) * K; return true; }
    __device__ __forceinline__ void a_ready(const Unit&) const {}
    __device__ __forceinline__ void done(const Unit&) const {}
};
__device__ __forceinline__ float sigm_f(float x) { return __builtin_amdgcn_rcpf(1.0f + __builtin_amdgcn_exp2f(-1.4426950408889634f * x)); }
__device__ __forceinline__ f32x4 sigm4(f32x4 v) { return (f32x4){sigm_f(v[0]), sigm_f(v[1]), sigm_f(v[2]), sigm_f(v[3])}; }
__device__ __forceinline__ u32x4 pack8(f32x4 v0, f32x4 v1) { u32x4 w; w.x = cvt_pk_bf16(v0[0], v0[1]); w.y = cvt_pk_bf16(v0[2], v0[3]); w.z = cvt_pk_bf16(v1[0], v1[1]); w.w = cvt_pk_bf16(v1[2], v1[3]); return w; }
__device__ __forceinline__ f32x4 bf_lo4(unsigned a, unsigned b) { return (f32x4){__uint_as_float(a << 16), __uint_as_float(a & 0xffff0000u), __uint_as_float(b << 16), __uint_as_float(b & 0xffff0000u)}; }

template <int SIDE  > struct EpiIn {
    static constexpr bool PERM = true, AFTER_DRAIN = false, HAS_MID = false;
    unsigned char* ws; const float* qg; const float* kg;
    size_t oU, oSZ, oQ, oK, oV, oSAZ, oGCS, oGAS, oROPE;
    template <int ACT> __device__ __forceinline__ void act_store(const f32x4 (&acc)[2][2][4][2], bf16_t* base, int ldc, int colt, int row0, int wc, int fq) const {
        const int col0 = colt + wc * 32 + 8 * fq;
#pragma unroll
        for (int ai = 0; ai < 2; ++ai)
#pragma unroll
            for (int m = 0; m < 4; ++m) { bf16_t* rowp = base + (size_t)(row0 + ai * HALF + m * 16) * ldc + col0;
#pragma unroll
                for (int bj = 0; bj < 2; ++bj) { f32x4 v0 = acc[ai][bj][m][0], v1 = acc[ai][bj][m][1];
                    if (ACT == 1) { v0 = v0 * sigm4(v0); v1 = v1 * sigm4(v1); }
                    if (ACT == 2) { v0 = sigm4(v0); v1 = sigm4(v1); }
                    __builtin_nontemporal_store(pack8(v0, v1), (u32x4*)(rowp + bj * HALF)); } }
    }
    __device__ __forceinline__ void qk_store(bool ISQ, const f32x4 (&acc)[2][2][4][2], bf16_t* base, int ldc, int head, int row0, int fq) const {
        size_t z_ = 0; asm volatile("" : "+s"(z_));
        const float* g = (ISQ ? qg : kg) + z_; const float* rope = (const float*)(ws + oROPE) + z_;
        const float osc = ISQ ? 0.125f * 1.4426950408889634f : 1.0f;
#pragma unroll
        for (int ai = 0; ai < 2; ++ai)
#pragma unroll
            for (int m = 0; m < 4; ++m) {
                const int row = row0 + ai * HALF + m * 16;
                const int t = row & 2047; const bool real = row < 32768; const int rid = real ? (t >> 6) : 0, cid = real ? (t & 63) : 0;
                float ss = 0.f;
#pragma unroll
                for (int bj = 0; bj < 2; ++bj)
#pragma unroll
                    for (int n = 0; n < 2; ++n) { const f32x4 x = acc[ai][bj][m][n]; ss += (x[0] * x[0] + x[1] * x[1]) + (x[2] * x[2] + x[3] * x[3]); }
                ss += __shfl_xor(ss, 16); ss += __shfl_xor(ss, 32);
                const float rstd = osc / sqrtf(ss * (1.0f / 64.0f) + 1e-6f);
                bf16_t* rowp = base + (size_t)row * ldc + head * 64 + 8 * fq;
#pragma unroll
                for (int bj = 0; bj < 2; ++bj) {
                    const int pos = bj ? cid : rid;
                    const f32x4 c = *(const f32x4*)(rope + pos * 16 + 4 * fq), s = *(const f32x4*)(rope + 1024 + pos * 16 + 4 * fq);
                    const f32x4 g0 = *(const f32x4*)(g + 32 * bj + 4 * fq), g1 = *(const f32x4*)(g + 32 * bj + 16 + 4 * fq);
                    const f32x4 xa = acc[ai][bj][m][0] * rstd * g0, xb = acc[ai][bj][m][1] * rstd * g1;
                    const f32x4 o0 = xa * c - xb * s, o1 = xb * c + xa * s;
                    __builtin_nontemporal_store(pack8(o0, o1), (u32x4*)(rowp + bj * 32)); asm volatile("" ::: "memory"); }
            }
    }
    __device__ __forceinline__ void operator()(const f32x4 (&acc)[2][2][4][2], const Unit& u, int wr, int wc, int fr_, int fq_) const {
        int fr = fr_, fq = fq_; asm volatile("" : "+v"(fr), "+v"(fq));
        const int pn = u.pn, row0 = u.pm * BM + wr * 64 + fr;
        if constexpr (SIDE == 0) {
        if (pn < 8) {
            const int col0 = pn * 128 + wc * 32 + 8 * fq;
#pragma unroll
            for (int ai = 0; ai < 2; ++ai)
#pragma unroll
                for (int m = 0; m < 4; ++m) {
                    const f32x4 v0 = acc[ai][0][m][0] * sigm4(acc[ai][1][m][0]), v1 = acc[ai][0][m][1] * sigm4(acc[ai][1][m][1]);
                    __builtin_nontemporal_store(pack8(v0, v1), (u32x4*)((bf16_t*)(ws + oU) + (size_t)(row0 + ai * HALF + m * 16) * 1024 + col0)); }
        }
        else if (pn < 12) act_store<1>(acc, (bf16_t*)(ws + oSZ), 1024, (pn - 8) * 256, row0, wc, fq);
        else act_store<2>(acc, (bf16_t*)(ws + oGCS), 1024, (pn - 22) * 256, row0, wc, fq);
        } else {
        if (pn <= 16) { const bool isq = pn < 16; qk_store(isq, acc, (bf16_t*)(ws + (isq ? oQ : oK)), isq ? 1024 : 256, isq ? (pn - 12) * 4 + wc : wc, row0, fq); }
        else if (pn == 17) act_store<0>(acc, (bf16_t*)(ws + oV), 256, 0, row0, wc, fq);
        else if (pn < 22) act_store<1>(acc, (bf16_t*)(ws + oSAZ), 1024, (pn - 18) * 256, row0, wc, fq);
        else act_store<2>(acc, (bf16_t*)(ws + oGAS), 1024, (pn - 26) * 256, row0, wc, fq);
        }
    }
};
template <int MODE> struct EpiGate {
    static constexpr bool PERM = true, AFTER_DRAIN = false, HAS_MID = false;
    bf16_t* O; const bf16_t* G; const bf16_t* Tin;
    __device__ __forceinline__ void operator()(const f32x4 (&acc)[2][2][4][2], const Unit& u, int wr, int wc, int fr, int fq) const {
        const int row0 = u.pm * BM + wr * 64 + fr, col0 = u.pn * BM + wc * 32 + 8 * fq;
#pragma unroll
        for (int ai = 0; ai < 2; ++ai)
#pragma unroll
            for (int m = 0; m < 4; ++m) { const size_t off = (size_t)(row0 + ai * HALF + m * 16) * 1024 + col0;
#pragma unroll
                for (int bj = 0; bj < 2; ++bj) {
                    const u32x4 gw = *(const u32x4*)(G + off + bj * HALF);
                    f32x4 v0 = acc[ai][bj][m][0] * bf_lo4(gw.x, gw.y), v1 = acc[ai][bj][m][1] * bf_lo4(gw.z, gw.w);
                    if (MODE == 1) { const u32x4 tw = *(const u32x4*)(Tin + off + bj * HALF); v0 = v0 + bf_lo4(tw.x, tw.y); v1 = v1 + bf_lo4(tw.z, tw.w); }
                    if (MODE == 1) __builtin_nontemporal_store(pack8(v0, v1), (u32x4*)(O + off + bj * HALF)); else *(u32x4*)(O + off + bj * HALF) = pack8(v0, v1); } }
    }
};
struct EpiOut {
    static constexpr bool PERM = true, AFTER_DRAIN = false, HAS_MID = false;
    const float* X; float* O;
    __device__ __forceinline__ void operator()(const f32x4 (&acc)[2][2][4][2], const Unit& u, int wr, int wc, int fr, int fq) const {
        const int row0 = u.pm * BM + wr * 64 + fr, col0 = u.pn * BM + wc * 32 + 8 * fq;
#pragma unroll
        for (int ai = 0; ai < 2; ++ai)
#pragma unroll
            for (int m = 0; m < 4; ++m) { const size_t off = (size_t)(row0 + ai * HALF + m * 16) * 1024 + col0;
#pragma unroll
                for (int bj = 0; bj < 2; ++bj) {
                    const f32x4 x0 = *(const f32x4*)(X + off + bj * HALF), x1 = *(const f32x4*)(X + off + bj * HALF + 4);
                    *(f32x4*)(O + off + bj * HALF) = x0 + acc[ai][bj][m][0]; *(f32x4*)(O + off + bj * HALF + 4) = x1 + acc[ai][bj][m][1]; } }
    }
};
struct EpiMerge {
    static constexpr bool PERM = true, AFTER_DRAIN = false, HAS_MID = true;
    bf16_t* O; const bf16_t* GC; const bf16_t* GA;
    __device__ __forceinline__ void mid(f32x4 (&acc)[2][2][4][2], const Unit& u, int wr, int wc, int fr, int fq) const {
        const int row0 = u.pm * BM + wr * 64 + fr, col0 = u.pn * BM + wc * 32 + 8 * fq;
#pragma unroll
        for (int ai = 0; ai < 2; ++ai)
#pragma unroll
            for (int m = 0; m < 4; ++m) { const size_t off = (size_t)(row0 + ai * HALF + m * 16) * 1024 + col0;
#pragma unroll
                for (int bj = 0; bj < 2; ++bj) {
                    const u32x4 gc = *(const u32x4*)(GC + off + bj * HALF), ga = *(const u32x4*)(GA + off + bj * HALF);
                    const f32x4 a0 = bf_lo4(ga.x, ga.y), a1 = bf_lo4(ga.z, ga.w), c0 = bf_lo4(gc.x, gc.y), c1 = bf_lo4(gc.z, gc.w);
#pragma unroll
                    for (int e = 0; e < 4; ++e) { acc[ai][bj][m][0][e] *= c0[e] * __builtin_amdgcn_rcpf(fmaxf(a0[e], 1e-30f)); acc[ai][bj][m][1][e] *= c1[e] * __builtin_amdgcn_rcpf(fmaxf(a1[e], 1e-30f));     }
                    } }
    }
    __device__ __forceinline__ void two_pass(f32x4 (&acc)[2][2][4][2], const Unit& u, int wr, int wc, int fr, int fq) const { if (u.kofs == 0) mid(acc, u, wr, wc, fr, fq); else fin(acc, u, wr, wc, fr, fq); }
    __device__ __forceinline__ void fin(const f32x4 (&acc)[2][2][4][2], const Unit& u, int wr, int wc, int fr, int fq) const {
        const int row0 = u.pm * BM + wr * 64 + fr, col0 = u.pn * BM + wc * 32 + 8 * fq;
#pragma unroll
        for (int ai = 0; ai < 2; ++ai)
#pragma unroll
            for (int m = 0; m < 4; ++m) { const size_t off = (size_t)(row0 + ai * HALF + m * 16) * 1024 + col0;
#pragma unroll
                for (int bj = 0; bj < 2; ++bj) {
                    const u32x4 ga = *(const u32x4*)(GA + off + bj * HALF);
                    __builtin_nontemporal_store(pack8(acc[ai][bj][m][0] * bf_lo4(ga.x, ga.y), acc[ai][bj][m][1] * bf_lo4(ga.z, ga.w)), (u32x4*)(O + off + bj * HALF)); } }
    }
};

template <class Epi, class Sched, bool ALIGN_EPI = false, bool SP2 = false, int FP8 = 0>
__device__ __forceinline__ void gemm_phase(PG8_LAS unsigned char* lds, const Gemm g, const Sched& S, const Epi& E, int wave_id) {
    int lane_ = (int)__builtin_amdgcn_mbcnt_hi(~0u, __builtin_amdgcn_mbcnt_lo(~0u, 0u));
    const int wid = wave_id, wr = wid >> 2, wc = wid & 3;
    int nt_ = g.K / BK; asm volatile("" : "+s"(nt_));
    const int K = g.ld, nt = nt_;
    unsigned voffA[2], voffB[2]; int aoff, boff, fr, fq;
#define PG8_LANE_SETUP() do { asm volatile("" : "+v"(lane_)); const int tid_ = wid * 64 + lane_; fr = lane_ & 15; fq = lane_ >> 4; \
        _Pragma("unroll") for (int i = 0; i < 2; ++i) { int R, C; stage_rc(tid_ * 16 + i * 8192, R, C); const int Rb = Epi::PERM ? ((R & ~31) + perm32(R & 31)) : R; \
            voffA[i] = (unsigned)(R * K + C) * 2u; voffB[i] = (unsigned)(Rb * K + C) * 2u; } \
        aoff = lds_byte(wr * 64 + fr, fq * 8); boff = lds_byte(wc * 32 + fr, fq * 8); } while (0)
    PG8_LANE_SETUP();
    const size_t kstep = (size_t)(BK * 2);
    const size_t hstep = (size_t)HALF * K * 2;
    const size_t tstep = 2 * hstep;
    const unsigned ldsw = (unsigned)wid * 1024u;
#define PG8_SA(b, h) (((b) * 2 + (h)) * HTB)
#define PG8_SB(b, h) ((4 + (b) * 2 + (h)) * HTB)
#define PG8_STAGE(bufoff, gbase, voff) do { const unsigned long long gb_ = (unsigned long long)(gbase); \
        const char* sb_ = (const char*)(((unsigned long long)(unsigned)__builtin_amdgcn_readfirstlane((int)(gb_ >> 32)) << 32) | (unsigned long long)(unsigned)__builtin_amdgcn_readfirstlane((int)gb_));     \
        _Pragma("unroll") for (int _i = 0; _i < 2; ++_i) \
        __builtin_amdgcn_global_load_lds((const unsigned*)(sb_ + (voff)[_i]), (PG8_LAS unsigned*)(lds + (bufoff) + ldsw + _i * 8192), 16, 0, 0); } while (0)
#define PG8_LDA(dst, b, h) do { _Pragma("unroll") for (int m = 0; m < 4; ++m) _Pragma("unroll") for (int k = 0; k < 2; ++k) dst[m][k] = *(const PG8_LAS bf16x8*)(lds + PG8_SA(b, h) + aoff + m * 2048 + k * 1024); } while (0)
#define PG8_LDB(dst, b, h) do { _Pragma("unroll") for (int n = 0; n < 2; ++n) _Pragma("unroll") for (int k = 0; k < 2; ++k) dst[n][k] = *(const PG8_LAS bf16x8*)(lds + PG8_SB(b, h) + boff + n * 2048 + k * 1024); } while (0)
#define PG8_CAT(v) __builtin_shufflevector(__builtin_bit_cast(i32x4_t, v[0]), __builtin_bit_cast(i32x4_t, v[1]), 0, 1, 2, 3, 4, 5, 6, 7)
#define PG8_MMA(ai, bj, At, Bt) do { __builtin_amdgcn_s_setprio(1); \
        if constexpr (FP8) { _Pragma("unroll") for (int m = 0; m < 4; ++m) _Pragma("unroll") for (int n = 0; n < 2; ++n) \
            acc[ai][bj][m][n] = __builtin_amdgcn_mfma_scale_f32_16x16x128_f8f6f4(PG8_CAT(Bt[n]), PG8_CAT(At[m]), acc[ai][bj][m][n], 0, 0, 0, FP8_SCALE_B, 0, (FP8 == 2 ? FP8_SCALE_B : FP8_SCALE_A)); } \
        else { _Pragma("unroll") for (int m = 0; m < 4; ++m) _Pragma("unroll") for (int n = 0; n < 2; ++n) _Pragma("unroll") for (int k = 0; k < 2; ++k) \
        acc[ai][bj][m][n] = __builtin_amdgcn_mfma_f32_16x16x32_bf16(Bt[n][k], At[m][k], acc[ai][bj][m][n], 0, 0, 0); } __builtin_amdgcn_s_setprio(0); } while (0)
#define PG8_WAIT_V(n) asm volatile("s_waitcnt vmcnt(" #n ")" ::: "memory")
#define PG8_WAIT_L(n) asm volatile("s_waitcnt lgkmcnt(" #n ")" ::: "memory")
#define PG8_BAR __builtin_amdgcn_s_barrier()
#define PG8_SCHED __builtin_amdgcn_sched_barrier(0)
    Unit cur, nxt; int ui = 0;
    if (!S.next(0, cur)) return;
    f32x4 acc[2][2][4][2];
#pragma unroll
    for (int a = 0; a < 2; ++a)
#pragma unroll
        for (int b = 0; b < 2; ++b)
#pragma unroll
            for (int m = 0; m < 4; ++m)
#pragma unroll
                for (int n = 0; n < 2; ++n) acc[a][b][m][n] = (f32x4){0.f, 0.f, 0.f, 0.f};
    bf16x8 At[4][2], B0[2][2], B1[2][2];
    const char* cA = (const char*)g.A + (size_t)cur.pm * tstep + (size_t)cur.kofs * 2; const char* cB = (const char*)g.Bt + (size_t)cur.pb * tstep + (size_t)cur.kofs * 2;
    S.a_ready(cur);
    if constexpr (SP2) {
        PG8_STAGE(PG8_SB(0, 0), cB, voffB); PG8_STAGE(PG8_SB(0, 1), cB + hstep, voffB); PG8_STAGE(PG8_SA(0, 0), cA, voffA); PG8_STAGE(PG8_SA(0, 1), cA + hstep, voffA);
        if (wr == 1) PG8_BAR;
        PG8_WAIT_V(2); PG8_BAR;
        PG8_STAGE(PG8_SB(1, 0), cB + kstep, voffB); PG8_STAGE(PG8_SA(1, 0), cA + kstep, voffA); PG8_STAGE(PG8_SB(1, 1), cB + hstep + kstep, voffB);
        PG8_WAIT_V(6); PG8_BAR;
    } else {
        PG8_STAGE(PG8_SB(0, 0), cB, voffB); PG8_STAGE(PG8_SA(0, 0), cA, voffA); PG8_STAGE(PG8_SB(0, 1), cB + hstep, voffB); PG8_STAGE(PG8_SA(0, 1), cA + hstep, voffA);
        if (wr == 1) PG8_BAR;
        PG8_WAIT_V(4); PG8_BAR;
        PG8_STAGE(PG8_SB(1, 0), cB + kstep, voffB); PG8_STAGE(PG8_SA(1, 0), cA + kstep, voffA); PG8_STAGE(PG8_SB(1, 1), cB + hstep + kstep, voffB);
        PG8_WAIT_V(6); PG8_BAR;
    }
    for (;;) {
        const bool has_next = S.next(ui + 1, nxt);
        const char* nA = has_next ? (const char*)g.A + (size_t)nxt.pm * tstep + (size_t)nxt.kofs * 2 : cA; const char* nB = has_next ? (const char*)g.Bt + (size_t)nxt.pb * tstep + (size_t)nxt.kofs * 2 : cB;
        for (int t = 0; t < nt; t += 2) {
            const bool last = (t == nt - 2);
            const char* a1 = cA + (size_t)(t + 1) * kstep;
            const char* a2 = last ? nA : cA + (size_t)(t + 2) * kstep; const char* b2 = last ? nB : cB + (size_t)(t + 2) * kstep;
            const char* a3 = a2 + kstep; const char* b3 = b2 + kstep;
            if (last && has_next) S.a_ready(nxt);
            if constexpr (SP2) {
            PG8_LDB(B0, 0, 0); PG8_LDB(B1, 0, 1); PG8_SCHED; PG8_LDA(At, 0, 0); PG8_STAGE(PG8_SA(1, 1), a1 + hstep, voffA);
            PG8_WAIT_V(8); PG8_WAIT_L(0); PG8_BAR; PG8_MMA(0, 0, At, B0); PG8_MMA(0, 1, At, B1); PG8_BAR; PG8_SCHED;
            PG8_LDA(At, 0, 1); PG8_STAGE(PG8_SB(0, 0), b2, voffB); PG8_STAGE(PG8_SB(0, 1), b2 + hstep, voffB); PG8_STAGE(PG8_SA(0, 0), a2, voffA);
            PG8_WAIT_V(8); PG8_WAIT_L(0); PG8_BAR; PG8_MMA(1, 0, At, B0); PG8_MMA(1, 1, At, B1); PG8_BAR; PG8_SCHED;
            PG8_LDB(B0, 1, 0); PG8_LDB(B1, 1, 1); PG8_SCHED; PG8_LDA(At, 1, 0); PG8_STAGE(PG8_SA(0, 1), a2 + hstep, voffA);
            PG8_WAIT_V(8); PG8_WAIT_L(0); PG8_BAR; PG8_MMA(0, 0, At, B0); PG8_MMA(0, 1, At, B1); PG8_BAR; PG8_SCHED;
            PG8_LDA(At, 1, 1); PG8_STAGE(PG8_SB(1, 0), b3, voffB); PG8_STAGE(PG8_SB(1, 1), b3 + hstep, voffB); PG8_STAGE(PG8_SA(1, 0), a3, voffA);
            PG8_WAIT_V(8); PG8_WAIT_L(0); PG8_BAR; PG8_MMA(1, 0, At, B0); PG8_MMA(1, 1, At, B1); PG8_BAR; PG8_SCHED;
            } else {
            PG8_LDB(B0, 0, 0); PG8_SCHED; PG8_LDA(At, 0, 0); PG8_STAGE(PG8_SA(1, 1), a1 + hstep, voffA);
            PG8_WAIT_L(8); PG8_BAR; PG8_WAIT_L(0); PG8_MMA(0, 0, At, B0); PG8_BAR; PG8_SCHED;
            PG8_LDB(B1, 0, 1); PG8_STAGE(PG8_SB(0, 0), b2, voffB);
            PG8_BAR; PG8_WAIT_L(0); PG8_MMA(0, 1, At, B1); PG8_BAR;
            PG8_LDA(At, 0, 1); PG8_STAGE(PG8_SA(0, 0), a2, voffA);
            PG8_BAR; PG8_WAIT_L(0); PG8_MMA(1, 0, At, B0); PG8_BAR; PG8_SCHED;
            PG8_STAGE(PG8_SB(0, 1), b2 + hstep, voffB);
            PG8_WAIT_V(6); PG8_BAR; PG8_MMA(1, 1, At, B1); PG8_BAR;
            PG8_LDB(B0, 1, 0); PG8_SCHED; PG8_LDA(At, 1, 0); PG8_STAGE(PG8_SA(0, 1), a2 + hstep, voffA);
            PG8_WAIT_L(8); PG8_BAR; PG8_WAIT_L(0); PG8_MMA(0, 0, At, B0); PG8_BAR; PG8_SCHED;
            PG8_LDB(B1, 1, 1); PG8_STAGE(PG8_SB(1, 0), b3, voffB);
            PG8_BAR; PG8_WAIT_L(0); PG8_MMA(0, 1, At, B1); PG8_BAR;
            PG8_LDA(At, 1, 1); PG8_STAGE(PG8_SA(1, 0), a3, voffA);
            PG8_BAR; PG8_WAIT_L(0); PG8_MMA(1, 0, At, B0); PG8_BAR; PG8_SCHED;
            PG8_STAGE(PG8_SB(1, 1), b3 + hstep, voffB);
            PG8_WAIT_V(6); PG8_BAR; PG8_MMA(1, 1, At, B1); PG8_BAR;
            }
        }
        if constexpr (ALIGN_EPI) { if (wr == 0) PG8_BAR; }
        if constexpr (Epi::HAS_MID) { E.two_pass(acc, cur, wr, wc, fr, fq); } else
        if constexpr (!Epi::AFTER_DRAIN) { E(acc, cur, wr, wc, fr, fq); S.done(cur); }
        if (!has_next) break;
        if (!Epi::HAS_MID || cur.kofs != 0)
#pragma unroll
        for (int a = 0; a < 2; ++a)
#pragma unroll
            for (int b = 0; b < 2; ++b)
#pragma unroll
                for (int m = 0; m < 4; ++m)
#pragma unroll
                    for (int n = 0; n < 2; ++n) acc[a][b][m][n] = (f32x4){0.f, 0.f, 0.f, 0.f};
        cur = nxt; cA = nA; cB = nB; ++ui;
        PG8_LANE_SETUP();
        if constexpr (ALIGN_EPI) { if (wr == 1) PG8_BAR; }
    }
    PG8_WAIT_V(0);
    if constexpr (!ALIGN_EPI) { if (wr == 0) PG8_BAR; }
    PG8_BAR;
    if constexpr (Epi::AFTER_DRAIN) { E.fused(acc, cur, wr, wc, fr, fq, lds, wid, lane_); S.done(cur); }
#undef PG8_LANE_SETUP
#undef PG8_SA
#undef PG8_SB
#undef PG8_STAGE
#undef PG8_LDA
#undef PG8_LDB
#undef PG8_MMA
#undef PG8_CAT
#undef PG8_WAIT_V
#undef PG8_WAIT_L
#undef PG8_BAR
#undef PG8_SCHED
}
}

#ifndef PG8_SP2
#define PG8_SP2 true
#endif
#ifndef PG8_ALIGN
#define PG8_ALIGN true
#endif
#include <hip/hip_bf16.h>
#include <cmath>
namespace attn_body {
using bf16=__hip_bfloat16;
using bf16x8=__attribute__((ext_vector_type(8)))short;
using s16x4=__attribute__((ext_vector_type(4)))short;
using f32x16=__attribute__((ext_vector_type(16)))float;
using u32x4=__attribute__((ext_vector_type(4)))unsigned;
constexpr int BATCH=16,NHEAD=16,SEQ=2048,D=64,DM=NHEAD*D,KVP=256,META_ROW0=32768,OP=2048;
constexpr int NW=8,QBLK=32,QB=QBLK*NW,KVBLK=64,NQB=SEQ/QB;
constexpr int ATTN_PITCH=DM, ATTN_UNIT_ROWS=QB;
__device__ __forceinline__ int crow(int r,int hi){return (r&3)+8*(r>>2)+4*hi;}
#define SBAR() __builtin_amdgcn_sched_barrier(0)
__device__ __forceinline__ void cmask(f32x16&p0,f32x16&p1,int jb,int qrel,int hi){
  const float NEG=-INFINITY; int kb=64*jb+4*hi;
  #pragma unroll
  for(int r=0;r<16;++r){int kv=kb+(r&3)+8*(r>>2); if(kv>qrel)p0[r]=NEG; if(kv+32>qrel)p1[r]=NEG;}
}

constexpr int NSLOT=3, SLOTB=8192;
constexpr int LDS_K=0, LDS_V=NSLOT*SLOTB, LDS_WS=2*NSLOT*SLOTB, LDS_OST=LDS_WS+NW*64*4, LDS_BYTES=LDS_OST+NW*4096;
constexpr float C2=0.125f*1.4426950408889634f;
__device__ __forceinline__ void glds16(const void*gsrc,unsigned lds_dst){unsigned keep;
  asm volatile("s_mov_b32 %0, m0\n\ts_mov_b32 m0, %2\n\ts_nop 0\n\tglobal_load_lds_dwordx4 %1, off\n\ts_mov_b32 m0, %0":"=&s"(keep):"v"(gsrc),"s"(lds_dst):"memory");}
__device__ __forceinline__ float max3f(float a,float b,float c){float r;asm("v_max3_f32 %0, %1, %2, %3":"=v"(r):"v"(a),"v"(b),"v"(c));return r;}
__device__ __forceinline__ float max2f(float a,float b){float r;asm("v_max_f32_e32 %0, %1, %2":"=v"(r):"v"(a),"v"(b));return r;}
__device__ __forceinline__ float fadd_s(float a,float b){float r;asm("v_add_f32_e32 %0, %1, %2":"=v"(r):"v"(a),"v"(b));return r;}
__device__ __forceinline__ float fsub_s(float a,float b){float r;asm("v_sub_f32_e32 %0, %1, %2":"=v"(r):"v"(a),"v"(b));return r;}
typedef float f32x2_t __attribute__((ext_vector_type(2))); typedef __bf16 bf16x2_t __attribute__((ext_vector_type(2)));
__device__ __forceinline__ unsigned cvtpk_s(float lo,float hi){f32x2_t v={lo,hi};bf16x2_t b=__builtin_convertvector(v,bf16x2_t);return __builtin_bit_cast(unsigned,b);}
#define WAIT_BAR(N) asm volatile("s_waitcnt vmcnt(" #N ") lgkmcnt(0)\n\ts_barrier":::"memory")

__device__ __forceinline__ void qkt(f32x16&p0,f32x16&p1,const char*Kslot,const bf16x8*qr,const f32x16&negm,int r32,int hi){
  const char*kb=Kslot+hi*1024+r32*16;
  #pragma unroll
  for(int d0=0;d0<4;++d0){
    const bf16x8 b0=*reinterpret_cast<const bf16x8*>(kb+d0*2048);
    const bf16x8 b1=*reinterpret_cast<const bf16x8*>(kb+d0*2048+512);
    if(d0==0){p0=__builtin_amdgcn_mfma_f32_32x32x16_bf16(b0,qr[0],negm,0,0,0);p1=__builtin_amdgcn_mfma_f32_32x32x16_bf16(b1,qr[0],negm,0,0,0);}
    else{p0=__builtin_amdgcn_mfma_f32_32x32x16_bf16(b0,qr[d0],p0,0,0,0);p1=__builtin_amdgcn_mfma_f32_32x32x16_bf16(b1,qr[d0],p1,0,0,0);}}
}
typedef __attribute__((address_space(3))) const char* lds_cptr;
typedef short v4i16_t __attribute__((ext_vector_type(4)));
__device__ __forceinline__ void kload8(bf16x8*kf,lds_cptr kp){
  kf[0]=*(const __attribute__((address_space(3))) bf16x8*)(kp);      kf[1]=*(const __attribute__((address_space(3))) bf16x8*)(kp+512);
  kf[2]=*(const __attribute__((address_space(3))) bf16x8*)(kp+2048); kf[3]=*(const __attribute__((address_space(3))) bf16x8*)(kp+2560);
  kf[4]=*(const __attribute__((address_space(3))) bf16x8*)(kp+4096); kf[5]=*(const __attribute__((address_space(3))) bf16x8*)(kp+4608);
  kf[6]=*(const __attribute__((address_space(3))) bf16x8*)(kp+6144); kf[7]=*(const __attribute__((address_space(3))) bf16x8*)(kp+6656);
}
__device__ __forceinline__ void kload2(bf16x8*kf,lds_cptr kp,int j){ kf[2*j]=*(const __attribute__((address_space(3))) bf16x8*)(kp+j*2048); kf[2*j+1]=*(const __attribute__((address_space(3))) bf16x8*)(kp+j*2048+512); }
__device__ __forceinline__ s16x4 vtr(lds_cptr p){ return __builtin_bit_cast(s16x4,__builtin_amdgcn_ds_read_tr16_b64_v4i16((__attribute__((address_space(3))) v4i16_t*)p)); }
__device__ __forceinline__ float rowmax(const f32x16&p0,const f32x16&p1){
  float a=max3f(p0[0],p0[1],p1[0]),b=max3f(p0[2],p0[3],p1[1]);a=max3f(a,p1[2],p1[3]);
  #pragma unroll
  for(int r=4;r<16;r+=4){a=max3f(a,p0[r],p0[r+1]);b=max3f(b,p0[r+2],p0[r+3]);a=max3f(a,p1[r],p1[r+1]);b=max3f(b,p1[r+2],p1[r+3]);}
  const float m=max2f(a,b);
  auto rr=__builtin_amdgcn_permlane32_swap(__float_as_uint(m),__float_as_uint(m),false,false);
  return max2f(__uint_as_float(rr[0]),__uint_as_float(rr[1]));
}
__device__ __forceinline__ void pv(f32x16*o,int vb,bf16x8 pa0,bf16x8 pa1,bf16x8 pa2,bf16x8 pa3){
  #pragma unroll
  for(int d0=0;d0<2;++d0){s16x4 lo[4],hi[4];
    #pragma unroll
    for(int ks=0;ks<4;++ks){
      asm volatile("ds_read_b64_tr_b16 %0,%1 offset:%c2":"=&v"(lo[ks]):"v"(vb),"i"(d0*4096+ks*1024):"memory");
      asm volatile("ds_read_b64_tr_b16 %0,%1 offset:%c2":"=&v"(hi[ks]):"v"(vb),"i"(d0*4096+ks*1024+512):"memory");}
    asm volatile("s_waitcnt lgkmcnt(0)":::"memory");SBAR();
    #define PK(k) (bf16x8){lo[k][0],lo[k][1],lo[k][2],lo[k][3],hi[k][0],hi[k][1],hi[k][2],hi[k][3]}
    o[d0]=__builtin_amdgcn_mfma_f32_32x32x16_bf16(pa0,PK(0),o[d0],0,0,0);
    o[d0]=__builtin_amdgcn_mfma_f32_32x32x16_bf16(pa1,PK(1),o[d0],0,0,0);
    o[d0]=__builtin_amdgcn_mfma_f32_32x32x16_bf16(pa2,PK(2),o[d0],0,0,0);
    o[d0]=__builtin_amdgcn_mfma_f32_32x32x16_bf16(pa3,PK(3),o[d0],0,0,0);
    #undef PK
  }
}

#ifndef ATTN_STORE16
#define ATTN_STORE16(p,v) __builtin_nontemporal_store((v),(u32x4*)(p))
#endif
template<int THRL> __device__ __forceinline__ void attn_unit(int b,int h,int qb,const bf16*Q,const bf16*__restrict__ K,const bf16*__restrict__ V,bf16*O,const bf16*__restrict__ SAZ,char*shm,int wave_id){
  int lane_=(int)__builtin_amdgcn_mbcnt_hi(~0u,__builtin_amdgcn_mbcnt_lo(~0u,0u)); asm volatile("":"+v"(lane_)); const int lane=lane_,r32=lane&31,hi=lane>>5; const int wid=wave_id;
  const long rowbase=(long)b*SEQ; const int q0=qb*QB;
  const bf16*Qw=Q+(rowbase+q0+wid*QBLK)*DM+h*D;
  const int kvh=h>>2; const bf16*Kh=K+rowbase*KVP+kvh*D,*Vh=V+rowbase*KVP+kvh*D; const long metaoff=((long)META_ROW0-rowbase)*KVP;
  const unsigned lds0=(unsigned)(uintptr_t)shm;
  float*wsf=(float*)(shm+LDS_WS)+wid*64;
  const bf16*ksrc=Kh+(long)lane*KVP+wid*8;
  const bf16*vsrc=Vh+(long)(16*(wid&3)+(lane>>2))*KVP+(wid>>2)*32+(lane&3)*8;
  const unsigned kdst=lds0+LDS_K+wid*1024, vdst=lds0+LDS_V+wid*1024;
  #define TOFF(t) (((t)==0)?metaoff:(long)((t)-1)*KVBLK*KVP)
  #define DMA_K(t,slot) glds16(ksrc+TOFF(t),(unsigned)__builtin_amdgcn_readfirstlane(kdst+(slot)))
  #define DMA_V(t,slot) glds16(vsrc+TOFF(t),(unsigned)__builtin_amdgcn_readfirstlane(vdst+(slot)))
  const int vb0=(int)(lds0+LDS_V)+((lane>>4)&1)*32+(lane&3)*8+(4*hi+((lane&15)>>2))*64;
  const char*Kbase=shm+LDS_K; bf16x8 kf[8];
  const lds_cptr shm3=(lds_cptr)shm; const lds_cptr kp0=shm3+LDS_K+hi*1024+r32*16; const lds_cptr vp0=shm3+LDS_V+((lane>>4)&1)*32+(lane&3)*8+(4*hi+((lane&15)>>2))*64;
  constexpr int NT=33;
  DMA_K(0,0);DMA_V(0,0);DMA_K(1,SLOTB);
  bf16x8 qr[4];
  #pragma unroll
  for(int d0=0;d0<4;++d0)qr[d0]=*reinterpret_cast<const bf16x8*>(&Qw[(long)r32*DM+d0*16+hi*8]);
  float mhat=0.f,l_reg=0.f;f32x16 o[2];o[0]=f32x16{};o[1]=f32x16{};f32x16 negm=f32x16{};asm volatile("":"+v"(negm));
  const int qrel=wid*QBLK+r32;
  #define CMASK(P0,P1,t) do{}while(0)
  bool resc=false;
  #define START(P0,P1) do{ const float rm=rowmax(P0,P1); resc=false; \
    { const float dl=rm; mhat=fadd_s(mhat,dl); \
      _Pragma("unroll") for(int r=0;r<16;++r){P0[r]=fsub_s(P0[r],dl);P1[r]=fsub_s(P1[r],dl);} \
      _Pragma("unroll") for(int r=0;r<16;++r)negm[r]=-mhat; asm volatile("":"+v"(negm)); } \
    _Pragma("unroll") for(int r=0;r<16;++r)P0[r]=__builtin_amdgcn_exp2f(P0[r]); }while(0)
  #define RESC() do{ if(resc){ asm volatile("s_waitcnt lgkmcnt(0)":::"memory"); \
      _Pragma("unroll") for(int d_=0;d_<2;++d_) _Pragma("unroll") for(int r=0;r<16;++r)o[d_][r]*=wsf[crow(r,hi)]; } }while(0)
  f32x16 pA0,pA1,pB0,pB1;
  int sl_prev=0,sl_cur=0,sl_next=SLOTB;
  #define ROT() do{sl_prev=sl_cur;sl_cur=sl_next;sl_next=(sl_next==(NSLOT-1)*SLOTB)?0:sl_next+SLOTB;}while(0)
  DMA_K(2,2*SLOTB);
  WAIT_BAR(3);
  qkt(pA0,pA1,Kbase,qr,negm,r32,hi);asm volatile("s_nop 15\n\ts_nop 7":"+v"(pA0),"+v"(pA1));
  { const float NEG=-INFINITY; _Pragma("unroll") for(int r=8;r<16;++r)pA0[r]=NEG; _Pragma("unroll") for(int r=0;r<16;++r)pA1[r]=NEG; }
  START(pA0,pA1);
  _Pragma("unroll") for(int r=0;r<16;++r)pA1[r]=__builtin_amdgcn_exp2f(pA1[r]);
  WAIT_BAR(0);
  DMA_K(3,0);DMA_V(1,SLOTB);
  ROT();
  kload8(kf,kp0+sl_cur);
  WAIT_BAR(2);
  s16x4 vlo[8],vhi[8]; u32x4 pw0,pw1,pw2,pw3;
  #define PKW(P,B) cvtpk_s(P[B],P[B+1])
  #define PAF(k) __builtin_bit_cast(bf16x8,pw##k)
  #define VFR(i) (bf16x8){vlo[i][0],vlo[i][1],vlo[i][2],vlo[i][3],vhi[i][0],vhi[i][1],vhi[i][2],vhi[i][3]}
  #define PIN(x) asm volatile("":"+v"(x))
  #define MX3(a,b,c) __builtin_fmaxf(__builtin_fmaxf((a),(b)),(c))
  #define GAPA(MF,A0,A1,A2,A3,W0,W1,PW) do{ MF; sacc+=A0; sacc+=A1; sacc+=A2; sacc+=A3; PIN(sacc); W0; W1; PIN(PW); SBAR(); }while(0)
  #define EX(v) __builtin_amdgcn_exp2f(v)
  #define GAPB(MF,X,B) do{ MF; X[B]=EX(X[B]); X[B+1]=EX(X[B+1]); X[B+2]=EX(X[B+2]); X[B+3]=EX(X[B+3]); PIN(X); SBAR(); }while(0)
  #define VRD(i) do{ vlo[i]=vtr(vp_+(((i)>>2)*4096+((i)&3)*1024)); vhi[i]=vtr(vp_+(((i)>>2)*4096+((i)&3)*1024+512)); }while(0)
  #define KRD(G,j) do{ if(G){ kload2(kf,kp0+sl_next,j); SBAR(); } }while(0)
  #define STEP(C0,C1,P0,P1,t,GK,GV,GL) do{ SBAR(); \
    const lds_cptr vp_=vp0+sl_prev; \
    VRD(0); SBAR(); float sacc=(P0[0]+P0[1]); \
    GAPA(C0=__builtin_amdgcn_mfma_f32_32x32x16_bf16(kf[0],qr[0],negm,0,0,0), P0[2],P0[3],P0[4],P0[5],     pw0[0]=PKW(P0,0), pw0[1]=PKW(P0,2), pw0); \
    VRD(4); SBAR(); GAPA(C1=__builtin_amdgcn_mfma_f32_32x32x16_bf16(kf[1],qr[0],negm,0,0,0), P0[6],P0[7],P0[8],P0[9],     pw0[2]=PKW(P0,4), pw0[3]=PKW(P0,6), pw0); \
    VRD(1); SBAR(); GAPA(C0=__builtin_amdgcn_mfma_f32_32x32x16_bf16(kf[2],qr[1],C0,0,0,0),   P0[10],P0[11],P0[12],P0[13], pw1[0]=PKW(P0,8), pw1[1]=PKW(P0,10), pw1); \
    VRD(5); SBAR(); GAPA(C1=__builtin_amdgcn_mfma_f32_32x32x16_bf16(kf[3],qr[1],C1,0,0,0),   P0[14],P0[15],P1[0],P1[1],   pw1[2]=PKW(P0,12),pw1[3]=PKW(P0,14), pw1); \
    VRD(2); SBAR(); GAPA(C0=__builtin_amdgcn_mfma_f32_32x32x16_bf16(kf[4],qr[2],C0,0,0,0),   P1[2],P1[3],P1[4],P1[5],     pw2[0]=PKW(P1,0), pw2[1]=PKW(P1,2), pw2); \
    VRD(6); SBAR(); GAPA(C1=__builtin_amdgcn_mfma_f32_32x32x16_bf16(kf[5],qr[2],C1,0,0,0),   P1[6],P1[7],P1[8],P1[9],     pw2[2]=PKW(P1,4), pw2[3]=PKW(P1,6), pw2); \
    VRD(3); SBAR(); GAPA(C0=__builtin_amdgcn_mfma_f32_32x32x16_bf16(kf[6],qr[3],C0,0,0,0),   P1[10],P1[11],P1[12],P1[13], pw3[0]=PKW(P1,8), pw3[1]=PKW(P1,10), pw3); \
    VRD(7); SBAR(); GAPA(C1=__builtin_amdgcn_mfma_f32_32x32x16_bf16(kf[7],qr[3],C1,0,0,0),   P1[14],P1[15],0.f,0.f,       pw3[2]=PKW(P1,12),pw3[3]=PKW(P1,14), pw3); \
    l_reg+=sacc; \
    if(GK){DMA_K((t)+3,sl_cur);} if(GV){DMA_V((t)+1,sl_next);} \
    CMASK(C0,C1,t); \
    { float a=MX3(C0[0],C0[1],C1[0]),b=MX3(C0[2],C0[3],C1[1]); a=MX3(a,C1[2],C1[3]); \
      _Pragma("unroll") for(int r=4;r<16;r+=4){a=MX3(a,C0[r],C0[r+1]);b=MX3(b,C0[r+2],C0[r+3]);a=MX3(a,C1[r],C1[r+1]);b=MX3(b,C1[r+2],C1[r+3]);} \
      float rm=__builtin_fmaxf(a,b); { auto rr=__builtin_amdgcn_permlane32_swap(__float_as_uint(rm),__float_as_uint(rm),false,false); rm=__builtin_fmaxf(__uint_as_float(rr[0]),__uint_as_float(rr[1])); } \
      resc=false; \
      if(__builtin_expect(__any(rm>(float)THRL),0)){ const float dl=__builtin_fmaxf(rm,0.f); mhat+=dl; \
        _Pragma("unroll") for(int r=0;r<16;++r){C0[r]-=dl;C1[r]-=dl;} \
        _Pragma("unroll") for(int r=0;r<16;++r)negm[r]=-mhat; asm volatile("":"+v"(negm)); \
        const float f=__builtin_amdgcn_exp2f(-dl); l_reg*=f; if(hi==0)wsf[r32]=f; resc=true; } } \
    SBAR(); \
    GAPB(o[0]=__builtin_amdgcn_mfma_f32_32x32x16_bf16(PAF(0),VFR(0),o[0],0,0,0), C0,0); \
    GAPB(o[1]=__builtin_amdgcn_mfma_f32_32x32x16_bf16(PAF(0),VFR(4),o[1],0,0,0), C0,4); \
    KRD(GL,0); GAPB(o[0]=__builtin_amdgcn_mfma_f32_32x32x16_bf16(PAF(1),VFR(1),o[0],0,0,0), C0,8); \
    KRD(GL,1); GAPB(o[1]=__builtin_amdgcn_mfma_f32_32x32x16_bf16(PAF(1),VFR(5),o[1],0,0,0), C0,12); \
    KRD(GL,2); GAPB(o[0]=__builtin_amdgcn_mfma_f32_32x32x16_bf16(PAF(2),VFR(2),o[0],0,0,0), C1,0); \
    KRD(GL,3); GAPB(o[1]=__builtin_amdgcn_mfma_f32_32x32x16_bf16(PAF(2),VFR(6),o[1],0,0,0), C1,4); \
    GAPB(o[0]=__builtin_amdgcn_mfma_f32_32x32x16_bf16(PAF(3),VFR(3),o[0],0,0,0), C1,8); \
    GAPB(o[1]=__builtin_amdgcn_mfma_f32_32x32x16_bf16(PAF(3),VFR(7),o[1],0,0,0), C1,12); \
    }while(0)
  int t=1;


  for(;t+5<NT;t+=2){
    STEP(pB0,pB1,pA0,pA1,t,true,true,true);     WAIT_BAR(2); RESC(); ROT();
    STEP(pA0,pA1,pB0,pB1,t+1,true,true,true);   WAIT_BAR(2); RESC(); ROT();
  }


  #define ENDW(tt) do{ if((tt)+3<NT){WAIT_BAR(2);} else if((tt)+2<NT){WAIT_BAR(1);} else {WAIT_BAR(0);} }while(0)
  for(;t+2<NT;t+=2){
    STEP(pB0,pB1,pA0,pA1,t,(t+3<NT),(t+1<NT),(t+1<NT));       ENDW(t);   RESC(); ROT();
    STEP(pA0,pA1,pB0,pB1,t+1,(t+4<NT),(t+2<NT),(t+2<NT));     ENDW(t+1); RESC(); ROT();
  }
  STEP(pB0,pB1,pA0,pA1,NT-2,false,true,true); ENDW(NT-2); RESC(); ROT();
  STEP(pA0,pA1,pB0,pB1,NT-1,false,false,false); RESC();
  { float sacc=pA0[0]+pA0[1]; _Pragma("unroll") for(int r=2;r<16;++r)sacc+=pA0[r]; _Pragma("unroll") for(int r=0;r<16;++r)sacc+=pA1[r]; l_reg+=sacc;
    pw0=(u32x4){PKW(pA0,0),PKW(pA0,2),PKW(pA0,4),PKW(pA0,6)};pw1=(u32x4){PKW(pA0,8),PKW(pA0,10),PKW(pA0,12),PKW(pA0,14)};pw2=(u32x4){PKW(pA1,0),PKW(pA1,2),PKW(pA1,4),PKW(pA1,6)};pw3=(u32x4){PKW(pA1,8),PKW(pA1,10),PKW(pA1,12),PKW(pA1,14)};
    SBAR(); pv(o,vb0+sl_cur,PAF(0),PAF(1),PAF(2),PAF(3)); }
  #undef PKW
  #undef PAF
  #undef VFR
  #undef PIN
  #undef MX3
  #undef GAPA
  #undef GAPB
  #undef EX
  #undef VRD
  #undef KRD
  #undef STEP
  #undef ENDW
  {auto rr=__builtin_amdgcn_permlane32_swap(__float_as_uint(l_reg),__float_as_uint(l_reg),false,false);l_reg=__uint_as_float(rr[0])+__uint_as_float(rr[1]);}
  if(hi==0)wsf[32+r32]=l_reg;asm volatile("s_waitcnt lgkmcnt(0)":::"memory");
  float rli[16];
  #pragma unroll
  for(int r=0;r<16;++r)rli[r]=__builtin_amdgcn_rcpf(wsf[32+crow(r,hi)]);
  unsigned char*Ow=(unsigned char*)O+(rowbase+q0+wid*QBLK)*(long)DM+h*D;
  { bf16*stg=(bf16*)(shm+LDS_OST)+wid*2048;
    #pragma unroll
    for(int r=0;r<16;++r){const int orow=crow(r,hi);
      #pragma unroll
      for(int d0=0;d0<2;++d0)stg[orow*64+d0*32+r32]=__float2bfloat16(o[d0][r]*rli[r]);}
    asm volatile("s_waitcnt lgkmcnt(0)":::"memory");
    const bf16*Zw=SAZ+(rowbase+q0+wid*QBLK)*DM+h*D;
    #pragma unroll
    for(int i=0;i<4;++i){const int row=i*8+(lane>>3),ch=lane&7; const u32x4 v=*(const u32x4*)(stg+row*64+ch*8); const u32x4 z=*(const u32x4*)(Zw+(long)row*DM+ch*8); u32x4 w;
      float af[8];
      #pragma unroll
      for(int e=0;e<4;++e){ af[2*e]=64.f*__uint_as_float(v[e]<<16)*__uint_as_float(z[e]<<16); af[2*e+1]=64.f*__uint_as_float(v[e]&0xffff0000u)*__uint_as_float(z[e]&0xffff0000u); }
      int w0=0,w1=0; w0=__builtin_amdgcn_cvt_pk_fp8_f32(af[0],af[1],w0,false); w0=__builtin_amdgcn_cvt_pk_fp8_f32(af[2],af[3],w0,true); w1=__builtin_amdgcn_cvt_pk_fp8_f32(af[4],af[5],w1,false); w1=__builtin_amdgcn_cvt_pk_fp8_f32(af[6],af[7],w1,true);
      typedef unsigned u32x2_t __attribute__((ext_vector_type(2))); u32x2_t w8; w8.x=(unsigned)w0; w8.y=(unsigned)w1; (void)w; __builtin_nontemporal_store(w8,(u32x2_t*)(Ow+(long)row*DM+ch*8));} }
  asm volatile("s_waitcnt lgkmcnt(0)\n\ts_barrier":::"memory");
  #undef DMA_K
  #undef TOFF
  #undef DMA_V
  #undef CMASK
  #undef START
  #undef RESC
  #undef ROT
}
constexpr int ATTN_LDS_BYTES=LDS_BYTES;
struct AttnTensors { const bf16* Q; const bf16* K; const bf16* V; bf16* O; const bf16* SAZ; };
template<int THRL=8> __device__ __forceinline__ void attn_phase(char*lds,const AttnTensors&T,int vcu,int G,int wave_id){
  if(G==256){
    const int x=vcu>>5,v=vcu&31,s=v&7,hl=s>>1,qh=s&1;
    for(int r=0;r<2;++r){ const int grp=x*8+r*4+(v>>3), b=grp>>2, kvh=grp&3, h=kvh*4+hl;
      for(int j=0;j<4;++j) attn_unit<THRL>(b,h,4*qh+j,T.Q,T.K,T.V,T.O,T.SAZ,lds,wave_id); }
  } else {
    const int NU=BATCH*NHEAD*NQB, upc=(NU+G-1)/G;
    for(int i=0;i<upc;++i){ const int id=vcu*upc+i; if(id>=NU)break; const int bh=id/NQB, qb=id%NQB; attn_unit<THRL>(bh/NHEAD,bh%NHEAD,qb,T.Q,T.K,T.V,T.O,T.SAZ,lds,wave_id); }
  }
}
#undef SBAR
#undef WAIT_BAR
}
#include <hip/hip_cooperative_groups.h>
namespace cg = cooperative_groups;
constexpr int NWAVES = 8;
constexpr int MR = 32768, MP = 33024, DMODEL = 1024, NIN = 7680, SEQL = 2048, NBATCH = 16, NMETA = 16;
constexpr size_t MiB = 1u << 20;
constexpr size_t BIG = (size_t)MP * DMODEL * 2, SMALL = (size_t)MP * 256 * 2;
constexpr size_t WS_TAB = 0;
constexpr size_t WS_ROPE = 1 * MiB;
constexpr size_t WS_WIN = 2 * MiB, WS_WC = 17 * MiB, WS_WA = 19 * MiB, WS_WO = 21 * MiB;
constexpr size_t WS_XN = 24 * MiB;
constexpr size_t WS_U = WS_XN + BIG;
constexpr size_t WS_SZ = WS_U + BIG;
constexpr size_t WS_Q = WS_SZ + BIG;
constexpr size_t WS_SAZ = WS_Q + BIG, WS_GCS = WS_SAZ + BIG, WS_GAS = WS_GCS + BIG, WS_K = WS_GAS + BIG, WS_V = WS_K + SMALL, WS_END = WS_V + SMALL;
static_assert(WS_END <= 512 * MiB, "d_ws map");
constexpr int RING_BYTES = 131072, LDS_BYTES = 147456;
constexpr size_t OUT_XN8 = 0, OUT_W8 = 32 * MiB;

#define LAS __attribute__((address_space(3)))
typedef unsigned short bf16;
typedef unsigned v4u __attribute__((ext_vector_type(4)));
typedef unsigned v2u __attribute__((ext_vector_type(2)));
typedef float f32x4 __attribute__((ext_vector_type(4)));
typedef float f32x2 __attribute__((ext_vector_type(2)));
#define LDS_WAIT() asm volatile("s_waitcnt lgkmcnt(0)" ::: "memory")
__device__ __forceinline__ unsigned pk2(float lo, float hi) { return pg8::cvt_pk_bf16(lo, hi); }
__device__ __forceinline__ float wave_sum(float v) {
#pragma unroll
    for (int o = 1; o < 64; o <<= 1) v += __shfl_xor(v, o);
    return v;
}
__device__ __forceinline__ int in_src_col(int np) {
    const int pn = np >> 8, p = np & 255, bj = p >> 7, wc = (p >> 5) & 3, i = p & 31;
    const int d = 32 * bj + 16 * ((i >> 2) & 1) + 4 * (i >> 3) + (i & 3);
    if (pn < 8) return (bj ? 1024 : 0) + pn * 128 + (p & 127);
    if (pn < 12) return 2048 + (pn - 8) * 256 + p;
    if (pn < 16) return 3072 + ((pn - 12) * 4 + wc) * 64 + d;
    if (pn == 16) return 4096 + wc * 64 + d;
    if (pn == 17) return 4352 + p;
    if (pn < 22) return 4608 + (pn - 18) * 256 + p;
    return 5632 + (pn - 22) * 256 + p;
}
template <bool PERMUTE> __device__ __forceinline__ void p0_transpose_item(const float* W, int K, int N, bf16* WT, int ldk, unsigned char* W8, LAS float* scr, int item, int lane) {
    const int nblk = N / 32, kb = item / nblk, nb = item % nblk, k0 = 64 * kb, n0 = 32 * nb;
    const int sc = PERMUTE ? in_src_col(n0 + (lane & 31)) : n0 + (lane & 31);
    float wv[32];
#pragma unroll
    for (int i = 0; i < 32; ++i) wv[i] = W[(size_t)(k0 + 2 * i + (lane >> 5)) * N + sc];
#pragma unroll
    for (int i = 0; i < 32; ++i) scr[(2 * i + (lane >> 5)) * 33 + (lane & 31)] = wv[i];
    LDS_WAIT(); asm volatile("" ::: "memory");
    const int c = lane & 7;
#pragma unroll
    for (int j = 0; j < 4; ++j) { const int n = (lane >> 3) + 8 * j; const LAS float* s = scr + (8 * c) * 33 + n;
        v4u o; o.x = pk2(s[0 * 33], s[1 * 33]); o.y = pk2(s[2 * 33], s[3 * 33]); o.z = pk2(s[4 * 33], s[5 * 33]); o.w = pk2(s[6 * 33], s[7 * 33]);
        bool wbf = (WT != nullptr); if (PERMUTE) { const int pn = n0 >> 8; wbf = pn < 12 || pn == 16 || pn == 17 || (pn >= 22 && pn < 26); }
        if (wbf) *(v4u*)(WT + (size_t)(n0 + n) * ldk + k0 + 8 * c) = o;
        if (PERMUTE) { const int pn = n0 >> 8; if ((pn >= 12 && pn < 22) || pn >= 26) {
            const int pb = pn < 22 ? pn - 12 : pn - 16; int w0 = 0, w1 = 0;
            w0 = __builtin_amdgcn_cvt_pk_fp8_f32(64.f * s[0 * 33], 64.f * s[1 * 33], w0, false); w0 = __builtin_amdgcn_cvt_pk_fp8_f32(64.f * s[2 * 33], 64.f * s[3 * 33], w0, true);
            w1 = __builtin_amdgcn_cvt_pk_fp8_f32(64.f * s[4 * 33], 64.f * s[5 * 33], w1, false); w1 = __builtin_amdgcn_cvt_pk_fp8_f32(64.f * s[6 * 33], 64.f * s[7 * 33], w1, true);
            v2u o8; o8.x = (unsigned)w0; o8.y = (unsigned)w1; *(v2u*)(W8 + (size_t)(256 * pb + ((n0 + n) & 255)) * 1024 + k0 + 8 * c) = o8; } }
        else if (W8) { int w0 = 0, w1 = 0;
            w0 = __builtin_amdgcn_cvt_pk_fp8_f32(64.f * s[0 * 33], 64.f * s[1 * 33], w0, false); w0 = __builtin_amdgcn_cvt_pk_fp8_f32(64.f * s[2 * 33], 64.f * s[3 * 33], w0, true);
            w1 = __builtin_amdgcn_cvt_pk_fp8_f32(64.f * s[4 * 33], 64.f * s[5 * 33], w1, false); w1 = __builtin_amdgcn_cvt_pk_fp8_f32(64.f * s[6 * 33], 64.f * s[7 * 33], w1, true);
            v2u o8; o8.x = (unsigned)w0; o8.y = (unsigned)w1; *(v2u*)(W8 + (size_t)(n0 + n) * 1024 + k0 + 8 * c) = o8; } }
    LDS_WAIT(); asm volatile("" ::: "memory");
}
__device__ __forceinline__ void rms_row_to_bf16(const float* xrow, const float* g, bf16* orow, unsigned char* orow8, int lane) {
    const f32x4* xr = (const f32x4*)xrow + lane; const f32x4* gr = (const f32x4*)g + lane;
    f32x4 v[4]; float s = 0.f;
#pragma unroll
    for (int j = 0; j < 4; ++j) { v[j] = xr[64 * j]; s += (v[j].x * v[j].x + v[j].y * v[j].y) + (v[j].z * v[j].z + v[j].w * v[j].w); }
    const float rstd = 1.f / sqrtf(wave_sum(s) * (1.f / 1024.f) + 1e-6f);
    v2u* o8 = (v2u*)orow + lane;
#pragma unroll
    for (int j = 0; j < 4; ++j) { const f32x4 y = v[j] * rstd * gr[64 * j]; v2u w; w.x = pk2(y.x, y.y); w.y = pk2(y.z, y.w); o8[64 * j] = w;
        if (orow8) { int q = 0; q = __builtin_amdgcn_cvt_pk_fp8_f32(y.x, y.y, q, false); q = __builtin_amdgcn_cvt_pk_fp8_f32(y.z, y.w, q, true); ((unsigned*)orow8)[lane + 64 * j] = (unsigned)q; } }
}
#define RLX_AGENT __ATOMIC_RELAXED, __HIP_MEMORY_SCOPE_AGENT
#define XB_TMO      128
#define XB_XCNT(j)  (256  + 64 * (j))
#define XB_XSUB(j)  (1280 + 64 * (j))
#define XB_XGEN(j)  (2304 + 64 * (j))
#define XB_TOP      3328
#define XB_TOPGEN   3392
#define XCD_BAR_WORDS 3456
#define XB_SPIN_CAP (1u << 18)

__device__ __forceinline__ unsigned xb_ld(unsigned* p)              { return __hip_atomic_load(p, __ATOMIC_RELAXED, __HIP_MEMORY_SCOPE_AGENT); }
__device__ __forceinline__ unsigned xb_add(unsigned* p, unsigned v) { return __hip_atomic_fetch_add(p, v, __ATOMIC_RELAXED, __HIP_MEMORY_SCOPE_AGENT); }
__device__ __forceinline__ unsigned xb_xcc_id() { return (unsigned)__builtin_amdgcn_s_getreg((3 << 11) | 20) & 0xFu; }
#define XB_SPIN(cond, bar) do { unsigned _sp = 0; while (cond) { __builtin_amdgcn_s_sleep(1); \
    if ((++_sp & 255u) == 0u) { if (xb_ld(&(bar)[XB_TMO])) break; if (_sp > XB_SPIN_CAP) { atomicAdd(&(bar)[XB_TMO], 1u); break; } } } } while (0)

struct XcdBarrier {
    unsigned* bar; unsigned x;
    volatile LAS unsigned* st;
};

__device__ __forceinline__ XcdBarrier xcd_barrier_post(unsigned* bar, volatile LAS unsigned* st, bool t0) {
    XcdBarrier b; b.bar = bar; b.x = xb_xcc_id(); b.st = st;
    if (t0) (void)xb_add(&bar[XB_XCNT(b.x)], 1u);
    return b;
}
__device__ __forceinline__ void xcd_barrier_complete(unsigned* bar, unsigned x, unsigned& nloc, unsigned& nx) {
    const unsigned G = gridDim.x * gridDim.y * gridDim.z;
    unsigned sum, cnt, mine, sp = 0u;
    for (;;) {
        sum = 0u; cnt = 0u; mine = 0u;
#pragma unroll
        for (unsigned j = 0; j < 16; ++j) { const unsigned c = xb_ld(&bar[XB_XCNT(j)]); sum += c; cnt += (c > 0u) ? 1u : 0u; mine = (j == x) ? c : mine; }
        if (sum == G) break;
        __builtin_amdgcn_s_sleep(1);
        if ((++sp & 255u) == 0u) { if (xb_ld(&bar[XB_TMO])) break; if (sp > XB_SPIN_CAP) { atomicAdd(&bar[XB_TMO], 1u); break; } }
    }
    nloc = mine > 0u ? mine : 1u; nx = cnt > 0u ? cnt : 1u;
}

__device__ __forceinline__ void xcd_barrier(const XcdBarrier& b, bool t0) {
    asm volatile("s_waitcnt vmcnt(0)" ::: "memory");
    __syncthreads();
    if (t0) {
        unsigned* bar = b.bar;
        __builtin_amdgcn_s_waitcnt(0);
        unsigned nloc = b.st[0], nx = b.st[1];
        if (nloc == 0u) { xcd_barrier_complete(bar, b.x, nloc, nx); b.st[0] = nloc; b.st[1] = nx; }
        const unsigned old = xb_add(&bar[XB_XSUB(b.x)], 1u);
        const unsigned gen = old / nloc;
        if (old + 1u == (gen + 1u) * nloc) {
            __builtin_amdgcn_fence(__ATOMIC_RELEASE, "agent");
            asm volatile("s_waitcnt vmcnt(0)" ::: "memory");
            const unsigned og = xb_add(&bar[XB_TOP], 1u);
            const unsigned tg = og / nx;
            if (og + 1u == (tg + 1u) * nx) xb_add(&bar[XB_TOPGEN], 1u);
            else XB_SPIN(xb_ld(&bar[XB_TOPGEN]) == tg, bar);
            __builtin_amdgcn_fence(__ATOMIC_ACQUIRE, "agent");
            xb_add(&bar[XB_XGEN(b.x)], 1u);
            asm volatile("s_waitcnt vmcnt(0)" ::: "memory");
        } else {
            XB_SPIN(xb_ld(&bar[XB_XGEN(b.x)]) == gen, bar);
            __builtin_amdgcn_fence(__ATOMIC_ACQUIRE, "agent");
            asm volatile("s_waitcnt vmcnt(0)" ::: "memory");
        }
    }
    __syncthreads();
}

constexpr size_t WS_CTL = 0, CTL_ZERO_BYTES = 65536; constexpr int CW_BAR = 1024;
constexpr int LDSCTL_OFF = RING_BYTES, MISC_OFF = LDSCTL_OFF + 320;
#define LANE_ID() ((int)__builtin_amdgcn_mbcnt_hi(~0u, __builtin_amdgcn_mbcnt_lo(~0u, 0u)))
struct Args { const float *x, *meta, *norm_g, *w_in, *conv_w, *conv_b, *cn_g, *cn_b, *w_conv_out, *q_g, *k_g, *w_attn_out, *w_out; float* out; unsigned char* ws; int ph_lo, ph_hi; };

__device__ __forceinline__ void p0_prologue(const Args& a, LAS unsigned char* lds, int vcu, int G, int tid, int lane, int wave) {
    unsigned char* ws = a.ws;
    LAS float* scr = (LAS float*)(lds + wave * 16384);
    const int gw = vcu * NWAVES + wave, NGW = G * NWAVES;
    constexpr int I_IN = (DMODEL / 64) * (NIN / 32), I_SQ = (DMODEL / 64) * (DMODEL / 32), NITEMS = I_IN + 3 * I_SQ;
    for (int it = gw; it < NITEMS; it += NGW) {
        int r = it;
        if (r < I_IN) { p0_transpose_item<true>(a.w_in, DMODEL, NIN, (bf16*)(ws + WS_WIN), DMODEL, (unsigned char*)a.out + OUT_W8, scr, r, lane); continue; } r -= I_IN;
        if (r < I_SQ) { p0_transpose_item<false>(a.w_conv_out, DMODEL, DMODEL, (bf16*)(ws + WS_WC), DMODEL, nullptr, scr, r, lane); continue; } r -= I_SQ;
        if (r < I_SQ) { p0_transpose_item<false>(a.w_attn_out, DMODEL, DMODEL, nullptr, 0, ws + WS_WA, scr, r, lane); continue; } r -= I_SQ;
        p0_transpose_item<false>(a.w_out, DMODEL, DMODEL, (bf16*)(ws + WS_WO), DMODEL, nullptr, scr, r, lane);
    }
    bf16* XN = (bf16*)(ws + WS_XN); unsigned char* XN8 = (unsigned char*)a.out + OUT_XN8;
    int m = gw;
    for (; m + NGW < MR; m += 2 * NGW) {
        const int m1 = m + NGW;
        const f32x4* x0 = (const f32x4*)(a.x + (size_t)m * DMODEL) + lane; const f32x4* x1 = (const f32x4*)(a.x + (size_t)m1 * DMODEL) + lane; const f32x4* gr = (const f32x4*)a.norm_g + lane;
        f32x4 v0[4], v1[4]; float s0 = 0.f, s1 = 0.f;
#pragma unroll
        for (int j = 0; j < 4; ++j) { v0[j] = x0[64 * j]; v1[j] = x1[64 * j]; }
#pragma unroll
        for (int j = 0; j < 4; ++j) { s0 += (v0[j].x * v0[j].x + v0[j].y * v0[j].y) + (v0[j].z * v0[j].z + v0[j].w * v0[j].w); s1 += (v1[j].x * v1[j].x + v1[j].y * v1[j].y) + (v1[j].z * v1[j].z + v1[j].w * v1[j].w); }
#pragma unroll
        for (int o = 1; o < 64; o <<= 1) { s0 += __shfl_xor(s0, o); s1 += __shfl_xor(s1, o); }
        const float r0 = 1.f / sqrtf(s0 * (1.f / 1024.f) + 1e-6f), r1 = 1.f / sqrtf(s1 * (1.f / 1024.f) + 1e-6f);
        v2u* o0 = (v2u*)(XN + (size_t)m * DMODEL) + lane; v2u* o1 = (v2u*)(XN + (size_t)m1 * DMODEL) + lane;
#pragma unroll
        for (int j = 0; j < 4; ++j) { const f32x4 gg = gr[64 * j]; const f32x4 y0 = v0[j] * r0 * gg, y1 = v1[j] * r1 * gg; v2u w0, w1; w0.x = pk2(y0.x, y0.y); w0.y = pk2(y0.z, y0.w); w1.x = pk2(y1.x, y1.y); w1.y = pk2(y1.z, y1.w); o0[64 * j] = w0; o1[64 * j] = w1;
            int q0 = 0, q1 = 0; q0 = __builtin_amdgcn_cvt_pk_fp8_f32(y0.x, y0.y, q0, false); q0 = __builtin_amdgcn_cvt_pk_fp8_f32(y0.z, y0.w, q0, true); q1 = __builtin_amdgcn_cvt_pk_fp8_f32(y1.x, y1.y, q1, false); q1 = __builtin_amdgcn_cvt_pk_fp8_f32(y1.z, y1.w, q1, true);
            ((unsigned*)(XN8 + (size_t)m * DMODEL))[lane + 64 * j] = (unsigned)q0; ((unsigned*)(XN8 + (size_t)m1 * DMODEL))[lane + 64 * j] = (unsigned)q1; }
    }
    for (; m < MR + 64; m += NGW) {
        if (m < MR) rms_row_to_bf16(a.x + (size_t)m * DMODEL, a.norm_g, XN + (size_t)m * DMODEL, XN8 + (size_t)m * DMODEL, lane);
        else if (m < MR + NMETA) rms_row_to_bf16(a.meta + (size_t)(m - MR) * DMODEL, a.norm_g, XN + (size_t)m * DMODEL, nullptr, lane);
        else { const v2u z = {0u, 0u};
            ((v2u*)((bf16*)(ws + WS_K) + (size_t)m * 256))[lane] = z; ((v2u*)((bf16*)(ws + WS_V) + (size_t)m * 256))[lane] = z; }
    }
    if (blockIdx.x == 0) {
        float* rope = (float*)(ws + WS_ROPE);
        for (int idx = tid; idx < 1024; idx += NWAVES * 64) { const int pos = idx >> 4, f = idx & 15;
            const float inv = __builtin_amdgcn_exp2f(-(float)f * (13.287712379549449f / 16.0f)); const float ang = (float)pos * inv;
            rope[idx] = __cosf(ang); rope[1024 + idx] = __sinf(ang); }
    }
}

__device__ __forceinline__ void conv_phase(unsigned char* ws, const Args& a, LAS unsigned char* lds, int vcu, int G, int tid, int lane, int wave) {
    const bf16* U = (const bf16*)(ws + WS_U); const bf16* SZ = (const bf16*)(ws + WS_SZ); bf16* C = (bf16*)a.out;
    const float* conv_w = a.conv_w; const float* conv_b = a.conv_b; const float* cn_g = a.cn_g; const float* cn_b = a.cn_b;
    const int NU = NBATCH * (SEQL / 32), upc = (NU + G - 1) / G, ch = 2 * tid;
    LAS float* tile = (LAS float*)lds;
    f32x2 w[31];
#pragma unroll
    for (int j = 0; j < 31; ++j) w[j] = *(const f32x2*)(conv_w + j * 1024 + ch);
    const f32x2 bias = *(const f32x2*)(conv_b + ch);
    for (int i = 0; i < upc; ++i) {
        const int id = vcu * upc + i; if (id >= NU) break;
        const int b = id >> 6, t0 = (id & 63) * 32;
        f32x2 acc[32];
#pragma unroll
        for (int o = 0; o < 32; ++o) acc[o] = bias;
        unsigned raw[3][8];
#define CONV_LOAD(g, dst, tie) do { int tb_ = t0 - 15 + 8 * (g); asm volatile("" : "+s"(tb_), "+v"(tie)); \
            _Pragma("unroll") for (int r = 0; r < 8; ++r) if (8 * (g) + r < 62) { const int tt = tb_ + r; \
                const int row = tt < 0 ? (MR + NMETA + tt) : (tt < SEQL ? b * SEQL + tt : b * SEQL + SEQL - 1); \
                dst[r] = *(const unsigned*)(U + (size_t)row * 1024 + ch); } } while (0)
        CONV_LOAD(0, raw[0], acc[0]); CONV_LOAD(1, raw[1], acc[0]);
#pragma unroll
        for (int g = 0; g < 8; ++g) {
            if (g + 2 < 8) { const int og = (8 * g - 8) < 0 ? 0 : ((8 * g - 8) > 31 ? 31 : (8 * g - 8)); CONV_LOAD(g + 2, raw[(g + 2) % 3], acc[og]); }
#pragma unroll
            for (int r = 0; r < 8; ++r) { const int ii = 8 * g + r; if (ii < 62) {
                const unsigned rw = raw[g % 3][r];
                f32x2 uv = {__uint_as_float(rw << 16), __uint_as_float(rw & 0xffff0000u)};
                if (t0 - 15 + ii >= SEQL) uv = (f32x2){0.f, 0.f};
#pragma unroll
                for (int o = 0; o < 32; ++o) { const int j = ii - o; if (j >= 0 && j <= 30) acc[o] += w[j] * uv; } } }
        }
#undef CONV_LOAD
#pragma unroll
        for (int o = 0; o < 32; ++o) *(LAS f32x2*)(tile + o * 1024 + ch) = acc[o];
        __syncthreads();
        {
            const size_t grow0 = (size_t)(b * SEQL + t0 + wave * 4) * 1024, crow0 = grow0;
            v2u zz[4][4];
#pragma unroll
            for (int k = 0; k < 4; ++k)
#pragma unroll
                for (int j = 0; j < 4; ++j) zz[k][j] = *(const v2u*)(SZ + grow0 + (size_t)k * 1024 + 4 * lane + 256 * j);
            f32x4 v[4][4]; float s[4];
#pragma unroll
            for (int k = 0; k < 4; ++k) { const LAS float* rp = tile + (wave * 4 + k) * 1024 + 4 * lane; s[k] = 0.f;
#pragma unroll
                for (int j = 0; j < 4; ++j) { v[k][j] = *(const LAS f32x4*)(rp + 256 * j); s[k] += (v[k][j].x + v[k][j].y) + (v[k][j].z + v[k][j].w); } }
#pragma unroll
            for (int o = 1; o < 64; o <<= 1)
#pragma unroll
                for (int k = 0; k < 4; ++k) s[k] += __shfl_xor(s[k], o);
            float s2[4];
#pragma unroll
            for (int k = 0; k < 4; ++k) { const float mean = s[k] * (1.f / 1024.f); s2[k] = 0.f;
#pragma unroll
                for (int j = 0; j < 4; ++j) { v[k][j] = v[k][j] - mean; s2[k] += (v[k][j].x * v[k][j].x + v[k][j].y * v[k][j].y) + (v[k][j].z * v[k][j].z + v[k][j].w * v[k][j].w); } }
#pragma unroll
            for (int o = 1; o < 64; o <<= 1)
#pragma unroll
                for (int k = 0; k < 4; ++k) s2[k] += __shfl_xor(s2[k], o);
#pragma unroll
            for (int j = 0; j < 4; ++j) { const int col = 4 * lane + 256 * j; const f32x4 g4 = *(const f32x4*)(cn_g + col), b4 = *(const f32x4*)(cn_b + col);
#pragma unroll
                for (int k = 0; k < 4; ++k) { const float rstd = 1.f / sqrtf(s2[k] * (1.f / 1024.f) + 1e-6f);
                    f32x4 y = v[k][j] * rstd * g4 + b4;
                    y = y * pg8::sigm4(y); y = y * pg8::bf_lo4(zz[k][j].x, zz[k][j].y);
                    v2u o; o.x = pk2(y.x, y.y); o.y = pk2(y.z, y.w); __builtin_nontemporal_store(o, (v2u*)(C + crow0 + (size_t)k * 1024 + col)); } }
        }
        __syncthreads();
    }
}

__device__ __forceinline__ void meta_proj(unsigned char* ws, const float* kg, LAS unsigned char* lds, int item, int wave, int lane) {
    typedef short bf16x8_t __attribute__((ext_vector_type(8)));
    const bf16* XN = (const bf16*)(ws + WS_XN); const bf16* WIN = (const bf16*)(ws + WS_WIN);
    bf16* U = (bf16*)(ws + WS_U); bf16* Kb = (bf16*)(ws + WS_K); bf16* Vb = (bf16*)(ws + WS_V);
    const int col = lane & 15, quad = lane >> 4;
    int nb[4]; int nblk;
    if (item < 64) { const int ch0 = 16 * item, pn = ch0 >> 7, j0 = ch0 & 127; nblk = 2; nb[0] = 256 * pn + j0; nb[1] = nb[0] + 128; nb[2] = nb[0]; nb[3] = nb[1]; }
    else if (item < 68) { const int hd = item - 64; nblk = 4; nb[0] = 4096 + 32 * hd; nb[1] = nb[0] + 16; nb[2] = nb[0] + 128; nb[3] = nb[2] + 16; }
    else { const int it = item - 68; nblk = 4; nb[0] = 4352 + 64 * it; nb[1] = nb[0] + 16; nb[2] = nb[0] + 32; nb[3] = nb[0] + 48; }
    f32x4 acc[4];
#pragma unroll
    for (int k = 0; k < 4; ++k) acc[k] = (f32x4){0.f, 0.f, 0.f, 0.f};
    const bf16* ap = XN + (size_t)(MR + col) * 1024 + 128 * wave + 8 * quad;
#pragma unroll
    for (int q = 0; q < 4; ++q) {
        const bf16x8_t av = *(const bf16x8_t*)(ap + 32 * q);
#pragma unroll
        for (int k = 0; k < 4; ++k) if (k < nblk) {
            const bf16x8_t bv = *(const bf16x8_t*)(WIN + (size_t)(nb[k] + col) * 1024 + 128 * wave + 32 * q + 8 * quad);
            acc[k] = __builtin_amdgcn_mfma_f32_16x16x32_bf16(av, bv, acc[k], 0, 0, 0); }
    }
    LAS f32x4* red = (LAS f32x4*)lds;
#pragma unroll
    for (int k = 0; k < 4; ++k) red[(wave * 4 + k) * 64 + lane] = acc[k];
    __syncthreads();
    if (wave == 0) {
#pragma unroll
        for (int k = 0; k < 4; ++k) { f32x4 s = red[k * 64 + lane];
#pragma unroll
            for (int w = 1; w < 8; ++w) s = s + red[(w * 4 + k) * 64 + lane];
            acc[k] = s; }
        if (item < 64) {
#pragma unroll
            for (int r = 0; r < 4; ++r) { const float u = acc[0][r] * pg8::sigm_f(acc[1][r]); U[(size_t)(MR + 4 * quad + r) * 1024 + 16 * item + col] = (bf16)(pk2(u, 0.f) & 0xffffu); }
        } else if (item < 68) {
            const int hd = item - 64;
#pragma unroll
            for (int r = 0; r < 4; ++r) { float ss = 0.f;
#pragma unroll
                for (int k = 0; k < 4; ++k) ss += acc[k][r] * acc[k][r];
                ss += __shfl_xor(ss, 1); ss += __shfl_xor(ss, 2); ss += __shfl_xor(ss, 4); ss += __shfl_xor(ss, 8);
                const float rstd = 1.0f / sqrtf(ss * (1.0f / 64.0f) + 1e-6f);
#pragma unroll
                for (int k = 0; k < 4; ++k) { const int bj = k >> 1, i32 = 16 * (k & 1) + col, dn = 32 * bj + 16 * ((i32 >> 2) & 1) + 4 * (i32 >> 3) + (i32 & 3);
                    const float v = acc[k][r] * rstd * kg[dn]; Kb[(size_t)(MR + 4 * quad + r) * 256 + hd * 64 + 32 * bj + i32] = (bf16)(pk2(v, 0.f) & 0xffffu); } }
        } else {
            const int it = item - 68;
#pragma unroll
            for (int r = 0; r < 4; ++r)
#pragma unroll
                for (int k = 0; k < 4; ++k) Vb[(size_t)(MR + 4 * quad + r) * 256 + 64 * it + 16 * k + col] = (bf16)(pk2(acc[k][r], 0.f) & 0xffffu);
        }
    }
    __syncthreads();
}

__global__ void __launch_bounds__(NWAVES * 64, 2) fwd_kernel(Args a) {
    extern __shared__ __attribute__((aligned(16))) unsigned char lds[];
    cg::grid_group grid = cg::this_grid();
    LAS unsigned char* l3 = (LAS unsigned char*)lds;
    const int wave = __builtin_amdgcn_readfirstlane(threadIdx.x >> 6);
#define GRID_SEAM() do { const bool t0_ = (wave == 0) && (LANE_ID() == 0); XcdBarrier xb_; xb_.bar = (unsigned*)(a.ws + WS_CTL) + CW_BAR; xb_.x = xb_xcc_id(); xb_.st = (volatile LAS unsigned*)(l3 + MISC_OFF) + 8; xcd_barrier(xb_, t0_); } while (0)
#define OPAQUE_WS() do { size_t z_ = 0; asm volatile("" : "+s"(z_)); ws = a.ws + z_; } while (0)
    const int G = gridDim.x, bx = blockIdx.x, vcu = (G % 8 == 0) ? (bx % 8) * (G / 8) + bx / 8 : bx;
    unsigned char* ws;
#define XN ((bf16*)(ws + WS_XN))
#define Ub ((bf16*)(ws + WS_U))
#define SZb ((bf16*)(ws + WS_SZ))
#define Qb ((bf16*)(ws + WS_Q))
#define SAZb ((bf16*)(ws + WS_SAZ))
#define GCSb ((bf16*)(ws + WS_GCS))
#define GASb ((bf16*)(ws + WS_GAS))
#define Kb ((bf16*)(ws + WS_K))
#define Vb ((bf16*)(ws + WS_V))
    for (int u = wave * 64 + LANE_ID(); u < (LDS_BYTES - LDSCTL_OFF) / 4; u += NWAVES * 64) ((LAS unsigned*)(l3 + LDSCTL_OFF))[u] = 0u;
    __syncthreads();
    (void)xcd_barrier_post((unsigned*)(a.ws + WS_CTL) + CW_BAR, (volatile LAS unsigned*)(l3 + MISC_OFF) + 8, (wave == 0) && (LANE_ID() == 0));
    if (a.ph_hi == 0x7fffffff) grid.sync();
#ifndef MK_REP_SYNC
#define MK_REP_SYNC 0
#endif
#define REP_SYNC() do { if (MK_REP_SYNC && rep_ > 0) GRID_SEAM(); } while (0)
#ifndef MK_REP_ATTN
#define MK_REP_ATTN 1
#endif
#ifndef MK_REP_SEAM
#define MK_REP_SEAM 1
#endif
#ifndef MK_REP_P0
#define MK_REP_P0 1
#endif
#ifndef MK_REP_P1
#define MK_REP_P1 1
#endif
#ifndef MK_REP_CONV
#define MK_REP_CONV 1
#endif
#ifndef MK_REP_P345
#define MK_REP_P345 1
#endif
#define IN(k) (a.ph_lo <= (k) && (k) < a.ph_hi)
#define SEAM(k) do { if (IN(k) && IN((k) + 1)) for (int rs_ = 0; rs_ < MK_REP_SEAM; ++rs_) GRID_SEAM(); OPAQUE_WS(); } while (0)
    OPAQUE_WS();
    if (IN(0)) for (int rep_ = 0; rep_ < MK_REP_P0; ++rep_) { const int lane = LANE_ID(), tid = wave * 64 + lane; p0_prologue(a, l3, vcu, G, tid, lane, wave); __syncthreads(); }
    SEAM(0);
    if (IN(1)) for (int rep_ = 0; rep_ < MK_REP_P1; ++rep_) { REP_SYNC();
        for (int item = bx; item < 72; item += G) { int lane = LANE_ID(); asm volatile("" : "+v"(lane)); meta_proj(ws, a.k_g, l3, item, wave, lane); }
        {
            pg8::Gemm g{XN, (const bf16*)(ws + WS_WIN), MR, 16 * 256, DMODEL, DMODEL}; pg8::RemapOrder S; S.base.init(MR, 16 * 256, G, bx); S.mode = 0;
            pg8::EpiIn<0> E{ws, a.q_g, a.k_g, WS_U, WS_SZ, WS_Q, WS_K, WS_V, WS_SAZ, WS_GCS, WS_GAS, WS_ROPE};
            pg8::gemm_phase<pg8::EpiIn<0>, pg8::RemapOrder, PG8_ALIGN, PG8_SP2, false>(l3, g, S, E, wave);
        }
        {
            pg8::Gemm g{(const bf16*)((const unsigned char*)a.out + OUT_XN8), (const bf16*)((const unsigned char*)a.out + OUT_W8), MR, 14 * 256, DMODEL / 2, DMODEL / 2}; pg8::RemapOrder S; S.base.init(MR, 14 * 256, G, bx); S.mode = 1;
            pg8::EpiIn<1> E{ws, a.q_g, a.k_g, WS_U, WS_SZ, WS_Q, WS_K, WS_V, WS_SAZ, WS_GCS, WS_GAS, WS_ROPE};
            pg8::gemm_phase<pg8::EpiIn<1>, pg8::RemapOrder, PG8_ALIGN, PG8_SP2, true>(l3, g, S, E, wave);
        }
    }
    SEAM(1);
    if (IN(2)) {
#pragma unroll 1
        for (int s_ = 0; s_ < 2; ++s_) {
            if ((s_ ^ (vcu & 1)) == 0) { int lane = LANE_ID(); asm volatile("" : "+v"(lane)); const int tid = wave * 64 + lane; conv_phase(ws, a, l3, vcu, G, tid, lane, wave); }
            else {
                const attn_body::AttnTensors AT{(const attn_body::bf16*)Qb, (const attn_body::bf16*)Kb, (const attn_body::bf16*)Vb, (attn_body::bf16*)((unsigned char*)a.out + 64 * MiB), (const attn_body::bf16*)SAZb};
                attn_body::attn_phase<8>((char*)lds, AT, vcu, G, wave);
            }
        }
    }
    SEAM(2);
    if (IN(3)) for (int rep_ = 0; rep_ < MK_REP_P345; ++rep_) { REP_SYNC();
        {
            pg8::Gemm g{(const bf16*)a.out, (const bf16*)(ws + WS_WC), MR, DMODEL, DMODEL, DMODEL}; pg8::StaticOrder S; S.init(MR, DMODEL, G, bx);
            pg8::EpiGate<0> E{Ub, GCSb, nullptr};
            pg8::gemm_phase<pg8::EpiGate<0>, pg8::StaticOrder, PG8_ALIGN, PG8_SP2, 0>(l3, g, S, E, wave);
        }
        {
            pg8::Gemm g{(const bf16*)((const unsigned char*)a.out + 64 * MiB), (const bf16*)(ws + WS_WA), MR, DMODEL, DMODEL / 2, DMODEL / 2}; pg8::StaticOrder S; S.init(MR, DMODEL, G, bx);
            pg8::EpiGate<1> E{SZb, GASb, Ub};
            pg8::gemm_phase<pg8::EpiGate<1>, pg8::StaticOrder, PG8_ALIGN, PG8_SP2, 2>(l3, g, S, E, wave);
        }
    }
    SEAM(3);
    if (IN(4)) for (int rep_ = 0; rep_ < MK_REP_P345; ++rep_) { REP_SYNC();
        pg8::Gemm g{SZb, (const bf16*)(ws + WS_WO), MR, DMODEL, DMODEL, DMODEL}; pg8::StaticOrder S; S.init(MR, DMODEL, G, bx);
        pg8::EpiOut E{a.x, a.out};
        pg8::gemm_phase<pg8::EpiOut, pg8::StaticOrder, PG8_ALIGN, PG8_SP2>(l3, g, S, E, wave);
    }
}

#ifdef MK_DIAG
__global__ void dump_k(const unsigned short* A, const unsigned short* B, float wa, float wb, float* o, int n) {
    int i = blockIdx.x * blockDim.x + threadIdx.x; if (i < n) o[i] = wa * __uint_as_float((unsigned)A[i] << 16) + wb * __uint_as_float((unsigned)B[i] << 16); }
#endif
extern "C" void kernel_launch(void* const* d_in, const int* in_sizes, int n_in, void* d_out, int out_size, void* d_ws, size_t ws_size, hipStream_t stream) {
    static int grid = 0;
    if (grid == 0) {
        if (n_in != 13 || out_size != MR * DMODEL || ws_size < WS_END) { fprintf(stderr, "kernel_launch: unexpected shapes (n_in %d, out %d, ws %zu)\n", n_in, out_size, ws_size); grid = -1; return; }
        int dev = 0, cus = 0, per_cu = 0;
        if (hipGetDevice(&dev) != hipSuccess || hipDeviceGetAttribute(&cus, hipDeviceAttributeMultiprocessorCount, dev) != hipSuccess) { grid = -1; return; }
        if (hipFuncSetAttribute((const void*)fwd_kernel, hipFuncAttributeMaxDynamicSharedMemorySize, LDS_BYTES) != hipSuccess) { fprintf(stderr, "kernel_launch: hipFuncSetAttribute failed\n"); grid = -1; return; }
        if (hipOccupancyMaxActiveBlocksPerMultiprocessor(&per_cu, (const void*)fwd_kernel, NWAVES * 64, LDS_BYTES) != hipSuccess || per_cu < 1) { fprintf(stderr, "kernel_launch: occupancy query says %d\n", per_cu); per_cu = 1; }
        (void)hipGetLastError();
        grid = cus;
    }
    if (grid < 0) return;
    Args a{};
    a.x = (const float*)d_in[0]; a.meta = (const float*)d_in[1]; a.norm_g = (const float*)d_in[2]; a.w_in = (const float*)d_in[3]; a.conv_w = (const float*)d_in[4]; a.conv_b = (const float*)d_in[5];
    a.cn_g = (const float*)d_in[6]; a.cn_b = (const float*)d_in[7]; a.w_conv_out = (const float*)d_in[8]; a.q_g = (const float*)d_in[9]; a.k_g = (const float*)d_in[10]; a.w_attn_out = (const float*)d_in[11];
    a.w_out = (const float*)d_in[12]; a.out = (float*)d_out; a.ws = (unsigned char*)d_ws;
#ifndef MK_N_LAUNCHES
#define MK_N_LAUNCHES 1
#endif
#ifdef MK_DIAG
    for (int li = 0; li < MK_DIAG; ++li) {
        a.ph_lo = li; a.ph_hi = li + 1; void* args[] = {&a};
        (void)hipLaunchCooperativeKernel((const void*)fwd_kernel, dim3(grid), dim3(NWAVES * 64), args, LDS_BYTES, stream);
    }
    dump_k<<<MR * DMODEL / 256, 256, 0, stream>>>((const unsigned short*)((char*)d_ws + MK_DIAG_A), (const unsigned short*)((char*)d_ws + MK_DIAG_B), MK_DIAG_WA, MK_DIAG_WB, (float*)d_out, MR * DMODEL);
    return;
#endif
    if (hipMemsetAsync((char*)d_ws + WS_CTL, 0, CTL_ZERO_BYTES, stream) != hipSuccess) { fprintf(stderr, "kernel_launch: hipMemsetAsync failed\n"); return; }
    for (int li = 0; li < MK_N_LAUNCHES; ++li) {
        a.ph_lo = (MK_N_LAUNCHES == 1) ? 0 : li; a.ph_hi = (MK_N_LAUNCHES == 1) ? 5 : li + 1;
        void* args[] = {&a};
        const hipError_t e = hipLaunchCooperativeKernel((const void*)fwd_kernel, dim3(grid), dim3(NWAVES * 64), args, LDS_BYTES, stream);
        if (e != hipSuccess) fprintf(stderr, "kernel_launch: cooperative launch failed: %s (grid %d)\n", hipGetErrorString(e), grid);
    }
}
```

```cpp
#include <hip/hip_runtime.h>
#include <cstdio>
#include <cstdint>
namespace pg8 {
#define PG8_LAS __attribute__((address_space(3)))
typedef unsigned short bf16_t;
typedef short bf16x8 __attribute__((ext_vector_type(8)));
typedef float f32x4 __attribute__((ext_vector_type(4)));
typedef unsigned u32x4 __attribute__((ext_vector_type(4)));
constexpr int BM = 256, BK = 64, HALF = 128, HTB = HALF * BK * 2  , STAGE_BYTES = 8 * HTB, NXCD = 8, WGM = 8;

__host__ __device__ __forceinline__ int lds_byte(int r, int c) { const int st = (r >> 4) * 2 + (c >> 5), rr = r & 15, cc = c & 31, ob = rr * 64 + cc * 2; return st * 1024 + (ob ^ (((ob >> 9) & 1) << 5)); }
__host__ __device__ __forceinline__ void stage_rc(int b, int& R, int& C) { const int st = b / 1024, sb = b % 1024, swz = sb ^ (((sb >> 9) & 1) << 5); R = (st >> 1) * 16 + swz / 64; C = (st & 1) * 32 + (swz % 64) / 2; }
__host__ __device__ __forceinline__ int perm32(int rho) { const int n = rho >> 4, i = rho & 15; return 8 * (i >> 2) + 4 * n + (i & 3); }

typedef int i32x4_t __attribute__((ext_vector_type(4))); typedef int i32x8_t __attribute__((ext_vector_type(8)));
constexpr int FP8_SCALE_A = 0x7f7f7f7f, FP8_SCALE_B = 0x79797979;
struct Unit { int pm, pn, kofs, pb; };
struct Gemm { const bf16_t* A; const bf16_t* Bt; int M, N, K, ld; };

struct StaticOrder {
    int nM, nN, nwg, G, c;
    __host__ __device__ void init(int M, int N, int G_, int c_) { nM = M / BM; nN = N / BM; nwg = nM * nN; G = G_; c = c_; }
    __host__ __device__ bool next(int i, Unit& u) const {
        const long L = (long)i * G + c; if (L >= nwg) return false;
        int wgid = (int)L; { const int q = nwg / NXCD, r = nwg % NXCD, xcd = wgid % NXCD, off = wgid / NXCD; wgid = (xcd < r ? xcd * (q + 1) : r * (q + 1) + (xcd - r) * q) + off; }
        const int nig = WGM * nN, gid = wgid / nig, fm = gid * WGM, gsz = (nM - fm) < WGM ? (nM - fm) : WGM;
        u.pm = fm + ((wgid % nig) % gsz); u.pn = (wgid % nig) / gsz; u.kofs = 0; u.pb = u.pn; return true;
    }
    __device__ __forceinline__ void a_ready(const Unit&) const {}
    __device__ __forceinline__ void done(const Unit&) const {}
};

typedef float f32x2c_t __attribute__((ext_vector_type(2))); typedef __bf16 bf16x2c_t __attribute__((ext_vector_type(2)));
__device__ __forceinline__ unsigned cvt_pk_bf16(float lo, float hi) { f32x2c_t v = {lo, hi}; bf16x2c_t b = __builtin_convertvector(v, bf16x2c_t); return __builtin_bit_cast(unsigned, b); }
typedef float f32x2 __attribute__((ext_vector_type(2)));
__device__ __forceinline__ f32x2 gelu_pk(f32x2 v) {
    const f32x2 av = __builtin_elementwise_abs(v), d = av * 0.2316418882f + 1.0f;
    f32x2 t; t.x = __builtin_amdgcn_rcpf(d.x); t.y = __builtin_amdgcn_rcpf(d.y);
    f32x2 q = t * 0.5307027145f + (-0.7265760135f); q = q * t + 0.7107068705f; q = q * t + (-0.142248368f); q = q * t + 0.127414796f; q = q * t;
    const f32x2 s = (v * v) * (-0.72134752044f);
    f32x2 e; e.x = __builtin_amdgcn_exp2f(s.x); e.y = __builtin_amdgcn_exp2f(s.y);
    const f32x2 m = v * (q * e), r = v - m;
    f32x2 o; o.x = v.x < 0.f ? m.x : r.x; o.y = v.y < 0.f ? m.y : r.y; return o;
}

template <int ACT  > struct EpiBf16 {
    static constexpr bool PERM = true, AFTER_DRAIN = false, HAS_MID = false; static_assert(ACT == 0 || ACT == 1, "EpiBf16: ACT is 0 (none) or 1 (gelu_pk)");
    bf16_t* O; int ldc; const float* bias; int split_cols; size_t split_stride; float scale0;
    __device__ __forceinline__ void operator()(const f32x4 (&acc)[2][2][4][2], const Unit& u, int wr, int wc, int fr, int fq) const {
        const int row0 = u.pm * BM + wr * 64 + fr; int colt = u.pn * BM; bf16_t* base = O;
        float sc = 1.f; if (split_cols) { const int t = colt / split_cols; base += (size_t)t * split_stride; colt -= t * split_cols; if (t == 0) sc = scale0; }
        const int col0 = colt + wc * 32 + 8 * fq, bcol0 = u.pn * BM + wc * 32 + 8 * fq;
        f32x4 bv[2][2];
#pragma unroll
        for (int bj = 0; bj < 2; ++bj)
#pragma unroll
            for (int n = 0; n < 2; ++n) bv[bj][n] = bias ? *(const f32x4*)(bias + bcol0 + bj * HALF + 4 * n) : (f32x4){0.f, 0.f, 0.f, 0.f};
#pragma unroll
        for (int ai = 0; ai < 2; ++ai)
#pragma unroll
            for (int m = 0; m < 4; ++m) { bf16_t* rowp = base + (size_t)(row0 + ai * HALF + m * 16) * ldc + col0;
#pragma unroll
                for (int bj = 0; bj < 2; ++bj) { f32x4 v0 = acc[ai][bj][m][0] + bv[bj][0], v1 = acc[ai][bj][m][1] + bv[bj][1];
                    if (ACT == 1) { f32x2 a = gelu_pk((f32x2){v0[0], v0[1]}), b = gelu_pk((f32x2){v0[2], v0[3]}), c = gelu_pk((f32x2){v1[0], v1[1]}), d = gelu_pk((f32x2){v1[2], v1[3]});
                        v0 = (f32x4){a.x, a.y, b.x, b.y}; v1 = (f32x4){c.x, c.y, d.x, d.y}; }
                    v0 = v0 * sc; v1 = v1 * sc; u32x4 w; w.x = cvt_pk_bf16(v0[0], v0[1]); w.y = cvt_pk_bf16(v0[2], v0[3]); w.z = cvt_pk_bf16(v1[0], v1[1]); w.w = cvt_pk_bf16(v1[2], v1[3]);
                    *(u32x4*)(rowp + bj * HALF) = w; } }
    }
};

struct RemapOrder {
    StaticOrder base; int mode;
    __host__ __device__ bool next(int i, Unit& u) const { if (!base.next(i, u)) return false; const int p = u.pn;
        if (mode == 0) { u.pn = p < 12 ? p : p + 10; u.pb = u.pn; } else { u.pn = p < 10 ? 12 + p : 16 + p; u.pb = p; } return true; }
    __device__ __forceinline__ void a_ready(const Unit&) const {}
    __device__ __forceinline__ void done(const Unit&) const {}
};
struct TwoPassOrder {
    StaticOrder base; int K;
    __host__ __device__ bool next(int i, Unit& u) const { if (!base.next(i >> 1, u)) return false; u.kofs = (i & 1) * K; return true; }
    __device__ __forceinline__ void a_ready(const Unit&) const {}
    __device__ __forceinline__ void done(const Unit&) const {}
};
__device__ __forceinline__ float sigm_f(float x) { return __builtin_amdgcn_rcpf(1.0f + __builtin_amdgcn_exp2f(-1.4426950408889634f * x)); }
__device__ __forceinline__ f32x4 sigm4(f32x4 v) { return (f32x4){sigm_f(v[0]), sigm_f(v[1]), sigm_f(v[2]), sigm_f(v[3])}; }
__device__ __forceinline__ u32x4 pack8(f32x4 v0, f32x4 v1) { u32x4 w; w.x = cvt_pk_bf16(v0[0], v0[1]); w.y = cvt_pk_bf16(v0[2], v0[3]); w.z = cvt_pk_bf16(v1[0], v1[1]); w.w = cvt_pk_bf16(v1[2], v1[3]); return w; }
__device__ __forceinline__ f32x4 bf_lo4(unsigned a, unsigned b) { return (f32x4){__uint_as_float(a << 16), __uint_as_float(a & 0xffff0000u), __uint_as_float(b << 16), __uint_as_float(b & 0xffff0000u)}; }

template <int SIDE  > struct EpiIn {
    static constexpr bool PERM = true, AFTER_DRAIN = false, HAS_MID = false;
    unsigned char* ws; const float* qg; const float* kg;
    size_t oU, oSZ, oQ, oK, oV, oSAZ, oGCS, oGAS, oROPE;
    template <int ACT> __device__ __forceinline__ void act_store(const f32x4 (&acc)[2][2][4][2], bf16_t* base, int ldc, int colt, int row0, int wc, int fq) const {
        const int col0 = colt + wc * 32 + 8 * fq;
#pragma unroll
        for (int ai = 0; ai < 2; ++ai)
#pragma unroll
            for (int m = 0; m < 4; ++m) { bf16_t* rowp = base + (size_t)(row0 + ai * HALF + m * 16) * ldc + col0;
#pragma unroll
                for (int bj = 0; bj < 2; ++bj) { f32x4 v0 = acc[ai][bj][m][0], v1 = acc[ai][bj][m][1];
                    if (ACT == 1) { v0 = v0 * sigm4(v0); v1 = v1 * sigm4(v1); }
                    if (ACT == 2) { v0 = sigm4(v0); v1 = sigm4(v1); }
                    __builtin_nontemporal_store(pack8(v0, v1), (u32x4*)(rowp + bj * HALF)); } }
    }
    __device__ __forceinline__ void qk_store(bool ISQ, const f32x4 (&acc)[2][2][4][2], bf16_t* base, int ldc, int head, int row0, int fq) const {
        size_t z_ = 0; asm volatile("" : "+s"(z_));
        const float* g = (ISQ ? qg : kg) + z_; const float* rope = (const float*)(ws + oROPE) + z_;
        const float osc = ISQ ? 0.125f * 1.4426950408889634f : 1.0f;
#pragma unroll
        for (int ai = 0; ai < 2; ++ai)
#pragma unroll
            for (int m = 0; m < 4; ++m) {
                const int row = row0 + ai * HALF + m * 16;
                const int t = row & 2047; const bool real = row < 32768; const int rid = real ? (t >> 6) : 0, cid = real ? (t & 63) : 0;
                float ss = 0.f;
#pragma unroll
                for (int bj = 0; bj < 2; ++bj)
#pragma unroll
                    for (int n = 0; n < 2; ++n) { const f32x4 x = acc[ai][bj][m][n]; ss += (x[0] * x[0] + x[1] * x[1]) + (x[2] * x[2] + x[3] * x[3]); }
                ss += __shfl_xor(ss, 16); ss += __shfl_xor(ss, 32);
                const float rstd = osc / sqrtf(ss * (1.0f / 64.0f) + 1e-6f);
                bf16_t* rowp = base + (size_t)row * ldc + head * 64 + 8 * fq;
#pragma unroll
                for (int bj = 0; bj < 2; ++bj) {
                    const int pos = bj ? cid : rid;
                    const f32x4 c = *(const f32x4*)(rope + pos * 16 + 4 * fq), s = *(const f32x4*)(rope + 1024 + pos * 16 + 4 * fq);
                    const f32x4 g0 = *(const f32x4*)(g + 32 * bj + 4 * fq), g1 = *(const f32x4*)(g + 32 * bj + 16 + 4 * fq);
                    const f32x4 xa = acc[ai][bj][m][0] * rstd * g0, xb = acc[ai][bj][m][1] * rstd * g1;
                    const f32x4 o0 = xa * c - xb * s, o1 = xb * c + xa * s;
                    __builtin_nontemporal_store(pack8(o0, o1), (u32x4*)(rowp + bj * 32)); asm volatile("" ::: "memory"); }
            }
    }
    __device__ __forceinline__ void operator()(const f32x4 (&acc)[2][2][4][2], const Unit& u, int wr, int wc, int fr_, int fq_) const {
        int fr = fr_, fq = fq_; asm volatile("" : "+v"(fr), "+v"(fq));
        const int pn = u.pn, row0 = u.pm * BM + wr * 64 + fr;
        if constexpr (SIDE == 0) {
        if (pn < 8) {
            const int col0 = pn * 128 + wc * 32 + 8 * fq;
#pragma unroll
            for (int ai = 0; ai < 2; ++ai)
#pragma unroll
                for (int m = 0; m < 4; ++m) {
                    const f32x4 v0 = acc[ai][0][m][0] * sigm4(acc[ai][1][m][0]), v1 = acc[ai][0][m][1] * sigm4(acc[ai][1][m][1]);
                    __builtin_nontemporal_store(pack8(v0, v1), (u32x4*)((bf16_t*)(ws + oU) + (size_t)(row0 + ai * HALF + m * 16) * 1024 + col0)); }
        }
        else if (pn < 12) act_store<1>(acc, (bf16_t*)(ws + oSZ), 1024, (pn - 8) * 256, row0, wc, fq);
        else act_store<2>(acc, (bf16_t*)(ws + oGCS), 1024, (pn - 22) * 256, row0, wc, fq);
        } else {
        if (pn <= 16) { const bool isq = pn < 16; qk_store(isq, acc, (bf16_t*)(ws + (isq ? oQ : oK)), isq ? 1024 : 256, isq ? (pn - 12) * 4 + wc : wc, row0, fq); }
        else if (pn == 17) act_store<0>(acc, (bf16_t*)(ws + oV), 256, 0, row0, wc, fq);
        else if (pn < 22) act_store<1>(acc, (bf16_t*)(ws + oSAZ), 1024, (pn - 18) * 256, row0, wc, fq);
        else act_store<2>(acc, (bf16_t*)(ws + oGAS), 1024, (pn - 26) * 256, row0, wc, fq);
        }
    }
};
template <int MODE> struct EpiGate {
    static constexpr bool PERM = true, AFTER_DRAIN = false, HAS_MID = false;
    bf16_t* O; const bf16_t* G; const bf16_t* Tin;
    __device__ __forceinline__ void operator()(const f32x4 (&acc)[2][2][4][2], const Unit& u, int wr, int wc, int fr, int fq) const {
        const int row0 = u.pm * BM + wr * 64 + fr, col0 = u.pn * BM + wc * 32 + 8 * fq;
#pragma unroll
        for (int ai = 0; ai < 2; ++ai)
#pragma unroll
            for (int m = 0; m < 4; ++m) { const size_t off = (size_t)(row0 + ai * HALF + m * 16) * 1024 + col0;
#pragma unroll
                for (int bj = 0; bj < 2; ++bj) {
                    const u32x4 gw = *(const u32x4*)(G + off + bj * HALF);
                    f32x4 v0 = acc[ai][bj][m][0] * bf_lo4(gw.x, gw.y), v1 = acc[ai][bj][m][1] * bf_lo4(gw.z, gw.w);
                    if (MODE == 1) { const u32x4 tw = *(const u32x4*)(Tin + off + bj * HALF); v0 = v0 + bf_lo4(tw.x, tw.y); v1 = v1 + bf_lo4(tw.z, tw.w); }
                    *(u32x4*)(O + off + bj * HALF) = pack8(v0, v1); } }
    }
};
struct EpiOut {
    static constexpr bool PERM = true, AFTER_DRAIN = false, HAS_MID = false;
    const float* X; float* O;
    __device__ __forceinline__ void operator()(const f32x4 (&acc)[2][2][4][2], const Unit& u, int wr, int wc, int fr, int fq) const {
        const int row0 = u.pm * BM + wr * 64 + fr, col0 = u.pn * BM + wc * 32 + 8 * fq;
#pragma unroll
        for (int ai = 0; ai < 2; ++ai)
#pragma unroll
            for (int m = 0; m < 4; ++m) { const size_t off = (size_t)(row0 + ai * HALF + m * 16) * 1024 + col0;
#pragma unroll
                for (int bj = 0; bj < 2; ++bj) {
                    const f32x4 x0 = *(const f32x4*)(X + off + bj * HALF), x1 = *(const f32x4*)(X + off + bj * HALF + 4);
                    *(f32x4*)(O + off + bj * HALF) = x0 + acc[ai][bj][m][0]; *(f32x4*)(O + off + bj * HALF + 4) = x1 + acc[ai][bj][m][1]; } }
    }
};
struct EpiMerge {
    static constexpr bool PERM = true, AFTER_DRAIN = false, HAS_MID = true;
    bf16_t* O; const bf16_t* GC; const bf16_t* GA;
    __device__ __forceinline__ void mid(f32x4 (&acc)[2][2][4][2], const Unit& u, int wr, int wc, int fr, int fq) const {
        const int row0 = u.pm * BM + wr * 64 + fr, col0 = u.pn * BM + wc * 32 + 8 * fq;
#pragma unroll
        for (int ai = 0; ai < 2; ++ai)
#pragma unroll
            for (int m = 0; m < 4; ++m) { const size_t off = (size_t)(row0 + ai * HALF + m * 16) * 1024 + col0;
#pragma unroll
                for (int bj = 0; bj < 2; ++bj) {
                    const u32x4 gc = *(const u32x4*)(GC + off + bj * HALF), ga = *(const u32x4*)(GA + off + bj * HALF);
                    const f32x4 a0 = bf_lo4(ga.x, ga.y), a1 = bf_lo4(ga.z, ga.w), c0 = bf_lo4(gc.x, gc.y), c1 = bf_lo4(gc.z, gc.w);
#pragma unroll
                    for (int e = 0; e < 4; ++e) { acc[ai][bj][m][0][e] *= c0[e] * __builtin_amdgcn_rcpf(fmaxf(a0[e], 1e-30f)); acc[ai][bj][m][1][e] *= c1[e] * __builtin_amdgcn_rcpf(fmaxf(a1[e], 1e-30f));     }
                    } }
    }
    __device__ __forceinline__ void two_pass(f32x4 (&acc)[2][2][4][2], const Unit& u, int wr, int wc, int fr, int fq) const { if (u.kofs == 0) mid(acc, u, wr, wc, fr, fq); else fin(acc, u, wr, wc, fr, fq); }
    __device__ __forceinline__ void fin(const f32x4 (&acc)[2][2][4][2], const Unit& u, int wr, int wc, int fr, int fq) const {
        const int row0 = u.pm * BM + wr * 64 + fr, col0 = u.pn * BM + wc * 32 + 8 * fq;
#pragma unroll
        for (int ai = 0; ai < 2; ++ai)
#pragma unroll
            for (int m = 0; m < 4; ++m) { const size_t off = (size_t)(row0 + ai * HALF + m * 16) * 1024 + col0;
#pragma unroll
                for (int bj = 0; bj < 2; ++bj) {
                    const u32x4 ga = *(const u32x4*)(GA + off + bj * HALF);
                    __builtin_nontemporal_store(pack8(acc[ai][bj][m][0] * bf_lo4(ga.x, ga.y), acc[ai][bj][m][1] * bf_lo4(ga.z, ga.w)), (u32x4*)(O + off + bj * HALF)); } }
    }
};

template <class Epi, class Sched, bool ALIGN_EPI = false, bool SP2 = false, bool FP8 = false>
__device__ __forceinline__ void gemm_phase(PG8_LAS unsigned char* lds, const Gemm g, const Sched& S, const Epi& E, int wave_id) {
    int lane_ = (int)__builtin_amdgcn_mbcnt_hi(~0u, __builtin_amdgcn_mbcnt_lo(~0u, 0u));
    const int wid = wave_id, wr = wid >> 2, wc = wid & 3;
    int nt_ = g.K / BK; asm volatile("" : "+s"(nt_));
    const int K = g.ld, nt = nt_;
    unsigned voffA[2], voffB[2]; int aoff, boff, fr, fq;
#define PG8_LANE_SETUP() do { asm volatile("" : "+v"(lane_)); const int tid_ = wid * 64 + lane_; fr = lane_ & 15; fq = lane_ >> 4; \
        _Pragma("unroll") for (int i = 0; i < 2; ++i) { int R, C; stage_rc(tid_ * 16 + i * 8192, R, C); const int Rb = Epi::PERM ? ((R & ~31) + perm32(R & 31)) : R; \
            voffA[i] = (unsigned)(R * K + C) * 2u; voffB[i] = (unsigned)(Rb * K + C) * 2u; } \
        aoff = lds_byte(wr * 64 + fr, fq * 8); boff = lds_byte(wc * 32 + fr, fq * 8); } while (0)
    PG8_LANE_SETUP();
    const size_t kstep = (size_t)(BK * 2);
    const size_t hstep = (size_t)HALF * K * 2;
    const size_t tstep = 2 * hstep;
    const unsigned ldsw = (unsigned)wid * 1024u;
#define PG8_SA(b, h) (((b) * 2 + (h)) * HTB)
#define PG8_SB(b, h) ((4 + (b) * 2 + (h)) * HTB)
#define PG8_STAGE(bufoff, gbase, voff) do { const unsigned long long gb_ = (unsigned long long)(gbase); \
        const char* sb_ = (const char*)(((unsigned long long)(unsigned)__builtin_amdgcn_readfirstlane((int)(gb_ >> 32)) << 32) | (unsigned long long)(unsigned)__builtin_amdgcn_readfirstlane((int)gb_));     \
        _Pragma("unroll") for (int _i = 0; _i < 2; ++_i) \
        __builtin_amdgcn_global_load_lds((const unsigned*)(sb_ + (voff)[_i]), (PG8_LAS unsigned*)(lds + (bufoff) + ldsw + _i * 8192), 16, 0, 0); } while (0)
#define PG8_LDA(dst, b, h) do { _Pragma("unroll") for (int m = 0; m < 4; ++m) _Pragma("unroll") for (int k = 0; k < 2; ++k) dst[m][k] = *(const PG8_LAS bf16x8*)(lds + PG8_SA(b, h) + aoff + m * 2048 + k * 1024); } while (0)
#define PG8_LDB(dst, b, h) do { _Pragma("unroll") for (int n = 0; n < 2; ++n) _Pragma("unroll") for (int k = 0; k < 2; ++k) dst[n][k] = *(const PG8_LAS bf16x8*)(lds + PG8_SB(b, h) + boff + n * 2048 + k * 1024); } while (0)
#define PG8_CAT(v) __builtin_shufflevector(__builtin_bit_cast(i32x4_t, v[0]), __builtin_bit_cast(i32x4_t, v[1]), 0, 1, 2, 3, 4, 5, 6, 7)
#define PG8_MMA(ai, bj, At, Bt) do { __builtin_amdgcn_s_setprio(1); \
        if constexpr (FP8) { _Pragma("unroll") for (int m = 0; m < 4; ++m) _Pragma("unroll") for (int n = 0; n < 2; ++n) \
            acc[ai][bj][m][n] = __builtin_amdgcn_mfma_scale_f32_16x16x128_f8f6f4(PG8_CAT(Bt[n]), PG8_CAT(At[m]), acc[ai][bj][m][n], 0, 0, 0, FP8_SCALE_B, 0, FP8_SCALE_A); } \
        else { _Pragma("unroll") for (int m = 0; m < 4; ++m) _Pragma("unroll") for (int n = 0; n < 2; ++n) _Pragma("unroll") for (int k = 0; k < 2; ++k) \
        acc[ai][bj][m][n] = __builtin_amdgcn_mfma_f32_16x16x32_bf16(Bt[n][k], At[m][k], acc[ai][bj][m][n], 0, 0, 0); } __builtin_amdgcn_s_setprio(0); } while (0)
#define PG8_WAIT_V(n) asm volatile("s_waitcnt vmcnt(" #n ")" ::: "memory")
#define PG8_WAIT_L(n) asm volatile("s_waitcnt lgkmcnt(" #n ")" ::: "memory")
#define PG8_BAR __builtin_amdgcn_s_barrier()
#define PG8_SCHED __builtin_amdgcn_sched_barrier(0)
    Unit cur, nxt; int ui = 0;
    if (!S.next(0, cur)) return;
    f32x4 acc[2][2][4][2];
#pragma unroll
    for (int a = 0; a < 2; ++a)
#pragma unroll
        for (int b = 0; b < 2; ++b)
#pragma unroll
            for (int m = 0; m < 4; ++m)
#pragma unroll
                for (int n = 0; n < 2; ++n) acc[a][b][m][n] = (f32x4){0.f, 0.f, 0.f, 0.f};
    bf16x8 At[4][2], B0[2][2], B1[2][2];
    const char* cA = (const char*)g.A + (size_t)cur.pm * tstep + (size_t)cur.kofs * 2; const char* cB = (const char*)g.Bt + (size_t)cur.pb * tstep + (size_t)cur.kofs * 2;
    S.a_ready(cur);
    if constexpr (SP2) {
        PG8_STAGE(PG8_SB(0, 0), cB, voffB); PG8_STAGE(PG8_SB(0, 1), cB + hstep, voffB); PG8_STAGE(PG8_SA(0, 0), cA, voffA); PG8_STAGE(PG8_SA(0, 1), cA + hstep, voffA);
        if (wr == 1) PG8_BAR;
        PG8_WAIT_V(2); PG8_BAR;
        PG8_STAGE(PG8_SB(1, 0), cB + kstep, voffB); PG8_STAGE(PG8_SA(1, 0), cA + kstep, voffA); PG8_STAGE(PG8_SB(1, 1), cB + hstep + kstep, voffB);
        PG8_WAIT_V(6); PG8_BAR;
    } else {
        PG8_STAGE(PG8_SB(0, 0), cB, voffB); PG8_STAGE(PG8_SA(0, 0), cA, voffA); PG8_STAGE(PG8_SB(0, 1), cB + hstep, voffB); PG8_STAGE(PG8_SA(0, 1), cA + hstep, voffA);
        if (wr == 1) PG8_BAR;
        PG8_WAIT_V(4); PG8_BAR;
        PG8_STAGE(PG8_SB(1, 0), cB + kstep, voffB); PG8_STAGE(PG8_SA(1, 0), cA + kstep, voffA); PG8_STAGE(PG8_SB(1, 1), cB + hstep + kstep, voffB);
        PG8_WAIT_V(6); PG8_BAR;
    }
    for (;;) {
        const bool has_next = S.next(ui + 1, nxt);
        const char* nA = has_next ? (const char*)g.A + (size_t)nxt.pm * tstep + (size_t)nxt.kofs * 2 : cA; const char* nB = has_next ? (const char*)g.Bt + (size_t)nxt.pb * tstep + (size_t)nxt.kofs * 2 : cB;
        for (int t = 0; t < nt; t += 2) {
            const bool last = (t == nt - 2);
            const char* a1 = cA + (size_t)(t + 1) * kstep;
            const char* a2 = last ? nA : cA + (size_t)(t + 2) * kstep; const char* b2 = last ? nB : cB + (size_t)(t + 2) * kstep;
            const char* a3 = a2 + kstep; const char* b3 = b2 + kstep;
            if (last && has_next) S.a_ready(nxt);
            if constexpr (SP2) {
            PG8_LDB(B0, 0, 0); PG8_LDB(B1, 0, 1); PG8_SCHED; PG8_LDA(At, 0, 0); PG8_STAGE(PG8_SA(1, 1), a1 + hstep, voffA);
            PG8_WAIT_V(8); PG8_WAIT_L(0); PG8_BAR; PG8_MMA(0, 0, At, B0); PG8_MMA(0, 1, At, B1); PG8_BAR; PG8_SCHED;
            PG8_LDA(At, 0, 1); PG8_STAGE(PG8_SB(0, 0), b2, voffB); PG8_STAGE(PG8_SB(0, 1), b2 + hstep, voffB); PG8_STAGE(PG8_SA(0, 0), a2, voffA);
            PG8_WAIT_V(8); PG8_WAIT_L(0); PG8_BAR; PG8_MMA(1, 0, At, B0); PG8_MMA(1, 1, At, B1); PG8_BAR; PG8_SCHED;
            PG8_LDB(B0, 1, 0); PG8_LDB(B1, 1, 1); PG8_SCHED; PG8_LDA(At, 1, 0); PG8_STAGE(PG8_SA(0, 1), a2 + hstep, voffA);
            PG8_WAIT_V(8); PG8_WAIT_L(0); PG8_BAR; PG8_MMA(0, 0, At, B0); PG8_MMA(0, 1, At, B1); PG8_BAR; PG8_SCHED;
            PG8_LDA(At, 1, 1); PG8_STAGE(PG8_SB(1, 0), b3, voffB); PG8_STAGE(PG8_SB(1, 1), b3 + hstep, voffB); PG8_STAGE(PG8_SA(1, 0), a3, voffA);
            PG8_WAIT_V(8); PG8_WAIT_L(0); PG8_BAR; PG8_MMA(1, 0, At, B0); PG8_MMA(1, 1, At, B1); PG8_BAR; PG8_SCHED;
            } else {
            PG8_LDB(B0, 0, 0); PG8_SCHED; PG8_LDA(At, 0, 0); PG8_STAGE(PG8_SA(1, 1), a1 + hstep, voffA);
            PG8_WAIT_L(8); PG8_BAR; PG8_WAIT_L(0); PG8_MMA(0, 0, At, B0); PG8_BAR; PG8_SCHED;
            PG8_LDB(B1, 0, 1); PG8_STAGE(PG8_SB(0, 0), b2, voffB);
            PG8_BAR; PG8_WAIT_L(0); PG8_MMA(0, 1, At, B1); PG8_BAR;
            PG8_LDA(At, 0, 1); PG8_STAGE(PG8_SA(0, 0), a2, voffA);
            PG8_BAR; PG8_WAIT_L(0); PG8_MMA(1, 0, At, B0); PG8_BAR; PG8_SCHED;
            PG8_STAGE(PG8_SB(0, 1), b2 + hstep, voffB);
            PG8_WAIT_V(6); PG8_BAR; PG8_MMA(1, 1, At, B1); PG8_BAR;
            PG8_LDB(B0, 1, 0); PG8_SCHED; PG8_LDA(At, 1, 0); PG8_STAGE(PG8_SA(0, 1), a2 + hstep, voffA);
            PG8_WAIT_L(8); PG8_BAR; PG8_WAIT_L(0); PG8_MMA(0, 0, At, B0); PG8_BAR; PG8_SCHED;
            PG8_LDB(B1, 1, 1); PG8_STAGE(PG8_SB(1, 0), b3, voffB);
            PG8_BAR; PG8_WAIT_L(0); PG8_MMA(0, 1, At, B1); PG8_BAR;
            PG8_LDA(At, 1, 1); PG8_STAGE(PG8_SA(1, 0), a3, voffA);
            PG8_BAR; PG8_WAIT_L(0); PG8_MMA(1, 0, At, B0); PG8_BAR; PG8_SCHED;
            PG8_STAGE(PG8_SB(1, 1), b3 + hstep, voffB);
            PG8_WAIT_V(6); PG8_BAR; PG8_MMA(1, 1, At, B1); PG8_BAR;
            }
        }
        if constexpr (ALIGN_EPI) { if (wr == 0) PG8_BAR; }
        if constexpr (Epi::HAS_MID) { E.two_pass(acc, cur, wr, wc, fr, fq); } else
        if constexpr (!Epi::AFTER_DRAIN) { E(acc, cur, wr, wc, fr, fq); S.done(cur); }
        if (!has_next) break;
        if (!Epi::HAS_MID || cur.kofs != 0)
#pragma unroll
        for (int a = 0; a < 2; ++a)
#pragma unroll
            for (int b = 0; b < 2; ++b)
#pragma unroll
                for (int m = 0; m < 4; ++m)
#pragma unroll
                    for (int n = 0; n < 2; ++n) acc[a][b][m][n] = (f32x4){0.f, 0.f, 0.f, 0.f};
        cur = nxt; cA = nA; cB = nB; ++ui;
        PG8_LANE_SETUP();
        if constexpr (ALIGN_EPI) { if (wr == 1) PG8_BAR; }
    }
    PG8_WAIT_V(0);
    if constexpr (!ALIGN_EPI) { if (wr == 0) PG8_BAR; }
    PG8_BAR;
    if constexpr (Epi::AFTER_DRAIN) { E.fused(acc, cur, wr, wc, fr, fq, lds, wid, lane_); S.done(cur); }
#undef PG8_LANE_SETUP
#undef PG8_SA
#undef PG8_SB
#undef PG8_STAGE
#undef PG8_LDA
#undef PG8_LDB
#undef PG8_MMA
#undef PG8_CAT
#undef PG8_WAIT_V
#undef PG8_WAIT_L
#undef PG8_BAR
#undef PG8_SCHED
}
}

#ifndef PG8_SP2
#define PG8_SP2 true
#endif
#ifndef PG8_ALIGN
#define PG8_ALIGN true
#endif
#include <hip/hip_bf16.h>
#include <cmath>
namespace attn_body {
using bf16=__hip_bfloat16;
using bf16x8=__attribute__((ext_vector_type(8)))short;
using s16x4=__attribute__((ext_vector_type(4)))short;
using f32x16=__attribute__((ext_vector_type(16)))float;
using u32x4=__attribute__((ext_vector_type(4)))unsigned;
constexpr int BATCH=16,NHEAD=16,SEQ=2048,D=64,DM=NHEAD*D,KVP=256,META_ROW0=32768,OP=2048;
constexpr int NW=8,QBLK=32,QB=QBLK*NW,KVBLK=64,NQB=SEQ/QB;
constexpr int ATTN_PITCH=DM, ATTN_UNIT_ROWS=QB;
__device__ __forceinline__ int crow(int r,int hi){return (r&3)+8*(r>>2)+4*hi;}
#define SBAR() __builtin_amdgcn_sched_barrier(0)
__device__ __forceinline__ void cmask(f32x16&p0,f32x16&p1,int jb,int qrel,int hi){
  const float NEG=-INFINITY; int kb=64*jb+4*hi;
  #pragma unroll
  for(int r=0;r<16;++r){int kv=kb+(r&3)+8*(r>>2); if(kv>qrel)p0[r]=NEG; if(kv+32>qrel)p1[r]=NEG;}
}

constexpr int NSLOT=3, SLOTB=8192;
constexpr int LDS_K=0, LDS_V=NSLOT*SLOTB, LDS_WS=2*NSLOT*SLOTB, LDS_OST=LDS_WS+NW*64*4, LDS_BYTES=LDS_OST+NW*4096;
constexpr float C2=0.125f*1.4426950408889634f;
__device__ __forceinline__ void glds16(const void*gsrc,unsigned lds_dst){unsigned keep;
  asm volatile("s_mov_b32 %0, m0\n\ts_mov_b32 m0, %2\n\ts_nop 0\n\tglobal_load_lds_dwordx4 %1, off\n\ts_mov_b32 m0, %0":"=&s"(keep):"v"(gsrc),"s"(lds_dst):"memory");}
__device__ __forceinline__ float max3f(float a,float b,float c){float r;asm("v_max3_f32 %0, %1, %2, %3":"=v"(r):"v"(a),"v"(b),"v"(c));return r;}
__device__ __forceinline__ float max2f(float a,float b){float r;asm("v_max_f32_e32 %0, %1, %2":"=v"(r):"v"(a),"v"(b));return r;}
__device__ __forceinline__ float fadd_s(float a,float b){float r;asm("v_add_f32_e32 %0, %1, %2":"=v"(r):"v"(a),"v"(b));return r;}
__device__ __forceinline__ float fsub_s(float a,float b){float r;asm("v_sub_f32_e32 %0, %1, %2":"=v"(r):"v"(a),"v"(b));return r;}
typedef float f32x2_t __attribute__((ext_vector_type(2))); typedef __bf16 bf16x2_t __attribute__((ext_vector_type(2)));
__device__ __forceinline__ unsigned cvtpk_s(float lo,float hi){f32x2_t v={lo,hi};bf16x2_t b=__builtin_convertvector(v,bf16x2_t);return __builtin_bit_cast(unsigned,b);}
#define WAIT_BAR(N) asm volatile("s_waitcnt vmcnt(" #N ") lgkmcnt(0)\n\ts_barrier":::"memory")

__device__ __forceinline__ void qkt(f32x16&p0,f32x16&p1,const char*Kslot,const bf16x8*qr,const f32x16&negm,int r32,int hi){
  const char*kb=Kslot+hi*1024+r32*16;
  #pragma unroll
  for(int d0=0;d0<4;++d0){
    const bf16x8 b0=*reinterpret_cast<const bf16x8*>(kb+d0*2048);
    const bf16x8 b1=*reinterpret_cast<const bf16x8*>(kb+d0*2048+512);
    if(d0==0){p0=__builtin_amdgcn_mfma_f32_32x32x16_bf16(b0,qr[0],negm,0,0,0);p1=__builtin_amdgcn_mfma_f32_32x32x16_bf16(b1,qr[0],negm,0,0,0);}
    else{p0=__builtin_amdgcn_mfma_f32_32x32x16_bf16(b0,qr[d0],p0,0,0,0);p1=__builtin_amdgcn_mfma_f32_32x32x16_bf16(b1,qr[d0],p1,0,0,0);}}
}
typedef __attribute__((address_space(3))) const char* lds_cptr;
typedef short v4i16_t __attribute__((ext_vector_type(4)));
__device__ __forceinline__ void kload8(bf16x8*kf,lds_cptr kp){
  kf[0]=*(const __attribute__((address_space(3))) bf16x8*)(kp);      kf[1]=*(const __attribute__((address_space(3))) bf16x8*)(kp+512);
  kf[2]=*(const __attribute__((address_space(3))) bf16x8*)(kp+2048); kf[3]=*(const __attribute__((address_space(3))) bf16x8*)(kp+2560);
  kf[4]=*(const __attribute__((address_space(3))) bf16x8*)(kp+4096); kf[5]=*(const __attribute__((address_space(3))) bf16x8*)(kp+4608);
  kf[6]=*(const __attribute__((address_space(3))) bf16x8*)(kp+6144); kf[7]=*(const __attribute__((address_space(3))) bf16x8*)(kp+6656);
}
__device__ __forceinline__ void kload2(bf16x8*kf,lds_cptr kp,int j){ kf[2*j]=*(const __attribute__((address_space(3))) bf16x8*)(kp+j*2048); kf[2*j+1]=*(const __attribute__((address_space(3))) bf16x8*)(kp+j*2048+512); }
__device__ __forceinline__ s16x4 vtr(lds_cptr p){ return __builtin_bit_cast(s16x4,__builtin_amdgcn_ds_read_tr16_b64_v4i16((__attribute__((address_space(3))) v4i16_t*)p)); }
__device__ __forceinline__ float rowmax(const f32x16&p0,const f32x16&p1){
  float a=max3f(p0[0],p0[1],p1[0]),b=max3f(p0[2],p0[3],p1[1]);a=max3f(a,p1[2],p1[3]);
  #pragma unroll
  for(int r=4;r<16;r+=4){a=max3f(a,p0[r],p0[r+1]);b=max3f(b,p0[r+2],p0[r+3]);a=max3f(a,p1[r],p1[r+1]);b=max3f(b,p1[r+2],p1[r+3]);}
  const float m=max2f(a,b);
  auto rr=__builtin_amdgcn_permlane32_swap(__float_as_uint(m),__float_as_uint(m),false,false);
  return max2f(__uint_as_float(rr[0]),__uint_as_float(rr[1]));
}
__device__ __forceinline__ void pv(f32x16*o,int vb,bf16x8 pa0,bf16x8 pa1,bf16x8 pa2,bf16x8 pa3){
  #pragma unroll
  for(int d0=0;d0<2;++d0){s16x4 lo[4],hi[4];
    #pragma unroll
    for(int ks=0;ks<4;++ks){
      asm volatile("ds_read_b64_tr_b16 %0,%1 offset:%c2":"=&v"(lo[ks]):"v"(vb),"i"(d0*4096+ks*1024):"memory");
      asm volatile("ds_read_b64_tr_b16 %0,%1 offset:%c2":"=&v"(hi[ks]):"v"(vb),"i"(d0*4096+ks*1024+512):"memory");}
    asm volatile("s_waitcnt lgkmcnt(0)":::"memory");SBAR();
    #define PK(k) (bf16x8){lo[k][0],lo[k][1],lo[k][2],lo[k][3],hi[k][0],hi[k][1],hi[k][2],hi[k][3]}
    o[d0]=__builtin_amdgcn_mfma_f32_32x32x16_bf16(pa0,PK(0),o[d0],0,0,0);
    o[d0]=__builtin_amdgcn_mfma_f32_32x32x16_bf16(pa1,PK(1),o[d0],0,0,0);
    o[d0]=__builtin_amdgcn_mfma_f32_32x32x16_bf16(pa2,PK(2),o[d0],0,0,0);
    o[d0]=__builtin_amdgcn_mfma_f32_32x32x16_bf16(pa3,PK(3),o[d0],0,0,0);
    #undef PK
  }
}

#ifndef ATTN_STORE16
#define ATTN_STORE16(p,v) __builtin_nontemporal_store((v),(u32x4*)(p))
#endif
template<int THRL> __device__ __forceinline__ void attn_unit(int b,int h,int qb,const bf16*Q,const bf16*__restrict__ K,const bf16*__restrict__ V,bf16*O,const bf16*__restrict__ SAZ,char*shm,int wave_id){
  int lane_=(int)__builtin_amdgcn_mbcnt_hi(~0u,__builtin_amdgcn_mbcnt_lo(~0u,0u)); asm volatile("":"+v"(lane_)); const int lane=lane_,r32=lane&31,hi=lane>>5; const int wid=wave_id;
  const long rowbase=(long)b*SEQ; const int q0=qb*QB;
  const bf16*Qw=Q+(rowbase+q0+wid*QBLK)*DM+h*D;
  const int kvh=h>>2; const bf16*Kh=K+rowbase*KVP+kvh*D,*Vh=V+rowbase*KVP+kvh*D; const long metaoff=((long)META_ROW0-rowbase)*KVP;
  const unsigned lds0=(unsigned)(uintptr_t)shm;
  float*wsf=(float*)(shm+LDS_WS)+wid*64;
  const bf16*ksrc=Kh+(long)lane*KVP+wid*8;
  const bf16*vsrc=Vh+(long)(16*(wid&3)+(lane>>2))*KVP+(wid>>2)*32+(lane&3)*8;
  const unsigned kdst=lds0+LDS_K+wid*1024, vdst=lds0+LDS_V+wid*1024;
  #define TOFF(t) (((t)==0)?metaoff:(long)((t)-1)*KVBLK*KVP)
  #define DMA_K(t,slot) glds16(ksrc+TOFF(t),(unsigned)__builtin_amdgcn_readfirstlane(kdst+(slot)))
  #define DMA_V(t,slot) glds16(vsrc+TOFF(t),(unsigned)__builtin_amdgcn_readfirstlane(vdst+(slot)))
  const int vb0=(int)(lds0+LDS_V)+((lane>>4)&1)*32+(lane&3)*8+(4*hi+((lane&15)>>2))*64;
  const char*Kbase=shm+LDS_K; bf16x8 kf[8];
  const lds_cptr shm3=(lds_cptr)shm; const lds_cptr kp0=shm3+LDS_K+hi*1024+r32*16; const lds_cptr vp0=shm3+LDS_V+((lane>>4)&1)*32+(lane&3)*8+(4*hi+((lane&15)>>2))*64;
  constexpr int NT=33;
  DMA_K(0,0);DMA_V(0,0);DMA_K(1,SLOTB);
  bf16x8 qr[4];
  #pragma unroll
  for(int d0=0;d0<4;++d0)qr[d0]=*reinterpret_cast<const bf16x8*>(&Qw[(long)r32*DM+d0*16+hi*8]);
  float mhat=0.f,l_reg=0.f;f32x16 o[2];o[0]=f32x16{};o[1]=f32x16{};f32x16 negm=f32x16{};asm volatile("":"+v"(negm));
  const int qrel=wid*QBLK+r32;
  #define CMASK(P0,P1,t) do{}while(0)
  bool resc=false;
  #define START(P0,P1) do{ const float rm=rowmax(P0,P1); resc=false; \
    { const float dl=rm; mhat=fadd_s(mhat,dl); \
      _Pragma("unroll") for(int r=0;r<16;++r){P0[r]=fsub_s(P0[r],dl);P1[r]=fsub_s(P1[r],dl);} \
      _Pragma("unroll") for(int r=0;r<16;++r)negm[r]=-mhat; asm volatile("":"+v"(negm)); } \
    _Pragma("unroll") for(int r=0;r<16;++r)P0[r]=__builtin_amdgcn_exp2f(P0[r]); }while(0)
  #define RESC() do{ if(resc){ asm volatile("s_waitcnt lgkmcnt(0)":::"memory"); \
      _Pragma("unroll") for(int d_=0;d_<2;++d_) _Pragma("unroll") for(int r=0;r<16;++r)o[d_][r]*=wsf[crow(r,hi)]; } }while(0)
  f32x16 pA0,pA1,pB0,pB1;
  int sl_prev=0,sl_cur=0,sl_next=SLOTB;
  #define ROT() do{sl_prev=sl_cur;sl_cur=sl_next;sl_next=(sl_next==(NSLOT-1)*SLOTB)?0:sl_next+SLOTB;}while(0)
  DMA_K(2,2*SLOTB);
  WAIT_BAR(3);
  qkt(pA0,pA1,Kbase,qr,negm,r32,hi);asm volatile("s_nop 15\n\ts_nop 7":"+v"(pA0),"+v"(pA1));
  { const float NEG=-INFINITY; _Pragma("unroll") for(int r=8;r<16;++r)pA0[r]=NEG; _Pragma("unroll") for(int r=0;r<16;++r)pA1[r]=NEG; }
  START(pA0,pA1);
  _Pragma("unroll") for(int r=0;r<16;++r)pA1[r]=__builtin_amdgcn_exp2f(pA1[r]);
  WAIT_BAR(0);
  DMA_K(3,0);DMA_V(1,SLOTB);
  ROT();
  kload8(kf,kp0+sl_cur);
  WAIT_BAR(2);
  s16x4 vlo[8],vhi[8]; u32x4 pw0,pw1,pw2,pw3;
  #define PKW(P,B) cvtpk_s(P[B],P[B+1])
  #define PAF(k) __builtin_bit_cast(bf16x8,pw##k)
  #define VFR(i) (bf16x8){vlo[i][0],vlo[i][1],vlo[i][2],vlo[i][3],vhi[i][0],vhi[i][1],vhi[i][2],vhi[i][3]}
  #define PIN(x) asm volatile("":"+v"(x))
  #define MX3(a,b,c) __builtin_fmaxf(__builtin_fmaxf((a),(b)),(c))
  #define GAPA(MF,A0,A1,A2,A3,W0,W1,PW) do{ MF; sacc+=A0; sacc+=A1; sacc+=A2; sacc+=A3; PIN(sacc); W0; W1; PIN(PW); SBAR(); }while(0)
  #define EX(v) __builtin_amdgcn_exp2f(v)
  #define GAPB(MF,X,B) do{ MF; X[B]=EX(X[B]); X[B+1]=EX(X[B+1]); X[B+2]=EX(X[B+2]); X[B+3]=EX(X[B+3]); PIN(X); SBAR(); }while(0)
  #define VRD(i) do{ vlo[i]=vtr(vp_+(((i)>>2)*4096+((i)&3)*1024)); vhi[i]=vtr(vp_+(((i)>>2)*4096+((i)&3)*1024+512)); }while(0)
  #define KRD(G,j) do{ if(G){ kload2(kf,kp0+sl_next,j); SBAR(); } }while(0)
  #define STEP(C0,C1,P0,P1,t,GK,GV,GL) do{ SBAR(); \
    const lds_cptr vp_=vp0+sl_prev; \
    VRD(0); SBAR(); float sacc=(P0[0]+P0[1]); \
    GAPA(C0=__builtin_amdgcn_mfma_f32_32x32x16_bf16(kf[0],qr[0],negm,0,0,0), P0[2],P0[3],P0[4],P0[5],     pw0[0]=PKW(P0,0), pw0[1]=PKW(P0,2), pw0); \
    VRD(4); SBAR(); GAPA(C1=__builtin_amdgcn_mfma_f32_32x32x16_bf16(kf[1],qr[0],negm,0,0,0), P0[6],P0[7],P0[8],P0[9],     pw0[2]=PKW(P0,4), pw0[3]=PKW(P0,6), pw0); \
    VRD(1); SBAR(); GAPA(C0=__builtin_amdgcn_mfma_f32_32x32x16_bf16(kf[2],qr[1],C0,0,0,0),   P0[10],P0[11],P0[12],P0[13], pw1[0]=PKW(P0,8), pw1[1]=PKW(P0,10), pw1); \
    VRD(5); SBAR(); GAPA(C1=__builtin_amdgcn_mfma_f32_32x32x16_bf16(kf[3],qr[1],C1,0,0,0),   P0[14],P0[15],P1[0],P1[1],   pw1[2]=PKW(P0,12),pw1[3]=PKW(P0,14), pw1); \
    VRD(2); SBAR(); GAPA(C0=__builtin_amdgcn_mfma_f32_32x32x16_bf16(kf[4],qr[2],C0,0,0,0),   P1[2],P1[3],P1[4],P1[5],     pw2[0]=PKW(P1,0), pw2[1]=PKW(P1,2), pw2); \
    VRD(6); SBAR(); GAPA(C1=__builtin_amdgcn_mfma_f32_32x32x16_bf16(kf[5],qr[2],C1,0,0,0),   P1[6],P1[7],P1[8],P1[9],     pw2[2]=PKW(P1,4), pw2[3]=PKW(P1,6), pw2); \
    VRD(3); SBAR(); GAPA(C0=__builtin_amdgcn_mfma_f32_32x32x16_bf16(kf[6],qr[3],C0,0,0,0),   P1[10],P1[11],P1[12],P1[13], pw3[0]=PKW(P1,8), pw3[1]=PKW(P1,10), pw3); \
    VRD(7); SBAR(); GAPA(C1=__builtin_amdgcn_mfma_f32_32x32x16_bf16(kf[7],qr[3],C1,0,0,0),   P1[14],P1[15],0.f,0.f,       pw3[2]=PKW(P1,12),pw3[3]=PKW(P1,14), pw3); \
    l_reg+=sacc; \
    if(GK){DMA_K((t)+3,sl_cur);} if(GV){DMA_V((t)+1,sl_next);} \
    CMASK(C0,C1,t); \
    { float a=MX3(C0[0],C0[1],C1[0]),b=MX3(C0[2],C0[3],C1[1]); a=MX3(a,C1[2],C1[3]); \
      _Pragma("unroll") for(int r=4;r<16;r+=4){a=MX3(a,C0[r],C0[r+1]);b=MX3(b,C0[r+2],C0[r+3]);a=MX3(a,C1[r],C1[r+1]);b=MX3(b,C1[r+2],C1[r+3]);} \
      float rm=__builtin_fmaxf(a,b); { auto rr=__builtin_amdgcn_permlane32_swap(__float_as_uint(rm),__float_as_uint(rm),false,false); rm=__builtin_fmaxf(__uint_as_float(rr[0]),__uint_as_float(rr[1])); } \
      resc=false; \
      if(__builtin_expect(__any(rm>(float)THRL),0)){ const float dl=__builtin_fmaxf(rm,0.f); mhat+=dl; \
        _Pragma("unroll") for(int r=0;r<16;++r){C0[r]-=dl;C1[r]-=dl;} \
        _Pragma("unroll") for(int r=0;r<16;++r)negm[r]=-mhat; asm volatile("":"+v"(negm)); \
        const float f=__builtin_amdgcn_exp2f(-dl); l_reg*=f; if(hi==0)wsf[r32]=f; resc=true; } } \
    SBAR(); \
    GAPB(o[0]=__builtin_amdgcn_mfma_f32_32x32x16_bf16(PAF(0),VFR(0),o[0],0,0,0), C0,0); \
    GAPB(o[1]=__builtin_amdgcn_mfma_f32_32x32x16_bf16(PAF(0),VFR(4),o[1],0,0,0), C0,4); \
    KRD(GL,0); GAPB(o[0]=__builtin_amdgcn_mfma_f32_32x32x16_bf16(PAF(1),VFR(1),o[0],0,0,0), C0,8); \
    KRD(GL,1); GAPB(o[1]=__builtin_amdgcn_mfma_f32_32x32x16_bf16(PAF(1),VFR(5),o[1],0,0,0), C0,12); \
    KRD(GL,2); GAPB(o[0]=__builtin_amdgcn_mfma_f32_32x32x16_bf16(PAF(2),VFR(2),o[0],0,0,0), C1,0); \
    KRD(GL,3); GAPB(o[1]=__builtin_amdgcn_mfma_f32_32x32x16_bf16(PAF(2),VFR(6),o[1],0,0,0), C1,4); \
    GAPB(o[0]=__builtin_amdgcn_mfma_f32_32x32x16_bf16(PAF(3),VFR(3),o[0],0,0,0), C1,8); \
    GAPB(o[1]=__builtin_amdgcn_mfma_f32_32x32x16_bf16(PAF(3),VFR(7),o[1],0,0,0), C1,12); \
    }while(0)
  int t=1;


  for(;t+5<NT;t+=2){
    STEP(pB0,pB1,pA0,pA1,t,true,true,true);     WAIT_BAR(2); RESC(); ROT();
    STEP(pA0,pA1,pB0,pB1,t+1,true,true,true);   WAIT_BAR(2); RESC(); ROT();
  }


  #define ENDW(tt) do{ if((tt)+3<NT){WAIT_BAR(2);} else if((tt)+2<NT){WAIT_BAR(1);} else {WAIT_BAR(0);} }while(0)
  for(;t+2<NT;t+=2){
    STEP(pB0,pB1,pA0,pA1,t,(t+3<NT),(t+1<NT),(t+1<NT));       ENDW(t);   RESC(); ROT();
    STEP(pA0,pA1,pB0,pB1,t+1,(t+4<NT),(t+2<NT),(t+2<NT));     ENDW(t+1); RESC(); ROT();
  }
  STEP(pB0,pB1,pA0,pA1,NT-2,false,true,true); ENDW(NT-2); RESC(); ROT();
  STEP(pA0,pA1,pB0,pB1,NT-1,false,false,false); RESC();
  { float sacc=pA0[0]+pA0[1]; _Pragma("unroll") for(int r=2;r<16;++r)sacc+=pA0[r]; _Pragma("unroll") for(int r=0;r<16;++r)sacc+=pA1[r]; l_reg+=sacc;
    pw0=(u32x4){PKW(pA0,0),PKW(pA0,2),PKW(pA0,4),PKW(pA0,6)};pw1=(u32x4){PKW(pA0,8),PKW(pA0,10),PKW(pA0,12),PKW(pA0,14)};pw2=(u32x4){PKW(pA1,0),PKW(pA1,2),PKW(pA1,4),PKW(pA1,6)};pw3=(u32x4){PKW(pA1,8),PKW(pA1,10),PKW(pA1,12),PKW(pA1,14)};
    SBAR(); pv(o,vb0+sl_cur,PAF(0),PAF(1),PAF(2),PAF(3)); }
  #undef PKW
  #undef PAF
  #undef VFR
  #undef PIN
  #undef MX3
  #undef GAPA
  #undef GAPB
  #undef EX
  #undef VRD
  #undef KRD
  #undef STEP
  #undef ENDW
  {auto rr=__builtin_amdgcn_permlane32_swap(__float_as_uint(l_reg),__float_as_uint(l_reg),false,false);l_reg=__uint_as_float(rr[0])+__uint_as_float(rr[1]);}
  if(hi==0)wsf[32+r32]=l_reg;asm volatile("s_waitcnt lgkmcnt(0)":::"memory");
  float rli[16];
  #pragma unroll
  for(int r=0;r<16;++r)rli[r]=__builtin_amdgcn_rcpf(wsf[32+crow(r,hi)]);
  bf16*Ow=O+(rowbase+q0+wid*QBLK)*OP+h*D;
  { bf16*stg=(bf16*)(shm+LDS_OST)+wid*2048;
    #pragma unroll
    for(int r=0;r<16;++r){const int orow=crow(r,hi);
      #pragma unroll
      for(int d0=0;d0<2;++d0)stg[orow*64+d0*32+r32]=__float2bfloat16(o[d0][r]*rli[r]);}
    asm volatile("s_waitcnt lgkmcnt(0)":::"memory");
    const bf16*Zw=SAZ+(rowbase+q0+wid*QBLK)*DM+h*D;
    #pragma unroll
    for(int i=0;i<4;++i){const int row=i*8+(lane>>3),ch=lane&7; const u32x4 v=*(const u32x4*)(stg+row*64+ch*8); const u32x4 z=*(const u32x4*)(Zw+(long)row*DM+ch*8); u32x4 w;
      #pragma unroll
      for(int e=0;e<4;++e){ const float a0=__uint_as_float(v[e]<<16)*__uint_as_float(z[e]<<16), a1=__uint_as_float(v[e]&0xffff0000u)*__uint_as_float(z[e]&0xffff0000u); w[e]=cvtpk_s(a0,a1);}
      ATTN_STORE16(Ow+(long)row*OP+ch*8,w);} }
  asm volatile("s_waitcnt lgkmcnt(0)\n\ts_barrier":::"memory");
  #undef DMA_K
  #undef TOFF
  #undef DMA_V
  #undef CMASK
  #undef START
  #undef RESC
  #undef ROT
}
constexpr int ATTN_LDS_BYTES=LDS_BYTES;
struct AttnTensors { const bf16* Q; const bf16* K; const bf16* V; bf16* O; const bf16* SAZ; };
template<int THRL=8> __device__ __forceinline__ void attn_phase(char*lds,const AttnTensors&T,int vcu,int G,int wave_id){
  if(G==256){
    const int x=vcu>>5,v=vcu&31,s=v&7,hl=s>>1,qh=s&1;
    for(int r=0;r<2;++r){ const int grp=x*8+r*4+(v>>3), b=grp>>2, kvh=grp&3, h=kvh*4+hl;
      for(int j=0;j<4;++j) attn_unit<THRL>(b,h,4*qh+j,T.Q,T.K,T.V,T.O,T.SAZ,lds,wave_id); }
  } else {
    const int NU=BATCH*NHEAD*NQB, upc=(NU+G-1)/G;
    for(int i=0;i<upc;++i){ const int id=vcu*upc+i; if(id>=NU)break; const int bh=id/NQB, qb=id%NQB; attn_unit<THRL>(bh/NHEAD,bh%NHEAD,qb,T.Q,T.K,T.V,T.O,T.SAZ,lds,wave_id); }
  }
}
#undef SBAR
#undef WAIT_BAR
}
#include <hip/hip_cooperative_groups.h>
namespace cg = cooperative_groups;
constexpr int NWAVES = 8;
constexpr int MR = 32768, MP = 33024, DMODEL = 1024, NIN = 7680, SEQL = 2048, NBATCH = 16, NMETA = 16;
constexpr size_t MiB = 1u << 20;
constexpr size_t BIG = (size_t)MP * DMODEL * 2, SMALL = (size_t)MP * 256 * 2;
constexpr size_t WS_TAB = 0;
constexpr size_t WS_ROPE = 1 * MiB;
constexpr size_t WS_WIN = 2 * MiB, WS_WC = 17 * MiB, WS_WA = 19 * MiB, WS_WO = 21 * MiB;
constexpr size_t WS_XN = 24 * MiB;
constexpr size_t WS_U = WS_XN + BIG;
constexpr size_t WS_SZ = WS_U + BIG;
constexpr size_t WS_Q = WS_SZ + BIG;
constexpr size_t WS_SAZ = WS_Q + BIG, WS_GCS = WS_SAZ + BIG, WS_GAS = WS_GCS + BIG, WS_K = WS_GAS + BIG, WS_V = WS_K + SMALL, WS_END = WS_V + SMALL;
static_assert(WS_END <= 512 * MiB, "d_ws map");
constexpr int RING_BYTES = 131072, LDS_BYTES = 147456;
constexpr size_t OUT_XN8 = 0, OUT_W8 = 32 * MiB;

#define LAS __attribute__((address_space(3)))
typedef unsigned short bf16;
typedef unsigned v4u __attribute__((ext_vector_type(4)));
typedef unsigned v2u __attribute__((ext_vector_type(2)));
typedef float f32x4 __attribute__((ext_vector_type(4)));
typedef float f32x2 __attribute__((ext_vector_type(2)));
#define LDS_WAIT() asm volatile("s_waitcnt lgkmcnt(0)" ::: "memory")
__device__ __forceinline__ unsigned pk2(float lo, float hi) { return pg8::cvt_pk_bf16(lo, hi); }
__device__ __forceinline__ float wave_sum(float v) {
#pragma unroll
    for (int o = 1; o < 64; o <<= 1) v += __shfl_xor(v, o);
    return v;
}
__device__ __forceinline__ int in_src_col(int np) {
    const int pn = np >> 8, p = np & 255, bj = p >> 7, wc = (p >> 5) & 3, i = p & 31;
    const int d = 32 * bj + 16 * ((i >> 2) & 1) + 4 * (i >> 3) + (i & 3);
    if (pn < 8) return (bj ? 1024 : 0) + pn * 128 + (p & 127);
    if (pn < 12) return 2048 + (pn - 8) * 256 + p;
    if (pn < 16) return 3072 + ((pn - 12) * 4 + wc) * 64 + d;
    if (pn == 16) return 4096 + wc * 64 + d;
    if (pn == 17) return 4352 + p;
    if (pn < 22) return 4608 + (pn - 18) * 256 + p;
    return 5632 + (pn - 22) * 256 + p;
}
template <bool PERMUTE> __device__ __forceinline__ void p0_transpose_item(const float* W, int K, int N, bf16* WT, int ldk, unsigned char* W8, LAS float* scr, int item, int lane) {
    const int nblk = N / 32, kb = item / nblk, nb = item % nblk, k0 = 64 * kb, n0 = 32 * nb;
    const int sc = PERMUTE ? in_src_col(n0 + (lane & 31)) : n0 + (lane & 31);
    float wv[32];
#pragma unroll
    for (int i = 0; i < 32; ++i) wv[i] = W[(size_t)(k0 + 2 * i + (lane >> 5)) * N + sc];
#pragma unroll
    for (int i = 0; i < 32; ++i) scr[(2 * i + (lane >> 5)) * 33 + (lane & 31)] = wv[i];
    LDS_WAIT(); asm volatile("" ::: "memory");
    const int c = lane & 7;
#pragma unroll
    for (int j = 0; j < 4; ++j) { const int n = (lane >> 3) + 8 * j; const LAS float* s = scr + (8 * c) * 33 + n;
        v4u o; o.x = pk2(s[0 * 33], s[1 * 33]); o.y = pk2(s[2 * 33], s[3 * 33]); o.z = pk2(s[4 * 33], s[5 * 33]); o.w = pk2(s[6 * 33], s[7 * 33]);
        bool wbf = true; if (PERMUTE) { const int pn = n0 >> 8; wbf = pn < 12 || pn == 16 || pn == 17 || (pn >= 22 && pn < 26); }
        if (wbf) *(v4u*)(WT + (size_t)(n0 + n) * ldk + k0 + 8 * c) = o;
        if (PERMUTE) { const int pn = n0 >> 8; if ((pn >= 12 && pn < 22) || pn >= 26) {
            const int pb = pn < 22 ? pn - 12 : pn - 16; int w0 = 0, w1 = 0;
            w0 = __builtin_amdgcn_cvt_pk_fp8_f32(64.f * s[0 * 33], 64.f * s[1 * 33], w0, false); w0 = __builtin_amdgcn_cvt_pk_fp8_f32(64.f * s[2 * 33], 64.f * s[3 * 33], w0, true);
            w1 = __builtin_amdgcn_cvt_pk_fp8_f32(64.f * s[4 * 33], 64.f * s[5 * 33], w1, false); w1 = __builtin_amdgcn_cvt_pk_fp8_f32(64.f * s[6 * 33], 64.f * s[7 * 33], w1, true);
            v2u o8; o8.x = (unsigned)w0; o8.y = (unsigned)w1; *(v2u*)(W8 + (size_t)(256 * pb + ((n0 + n) & 255)) * 1024 + k0 + 8 * c) = o8; } } }
    LDS_WAIT(); asm volatile("" ::: "memory");
}
__device__ __forceinline__ void rms_row_to_bf16(const float* xrow, const float* g, bf16* orow, unsigned char* orow8, int lane) {
    const f32x4* xr = (const f32x4*)xrow + lane; const f32x4* gr = (const f32x4*)g + lane;
    f32x4 v[4]; float s = 0.f;
#pragma unroll
    for (int j = 0; j < 4; ++j) { v[j] = xr[64 * j]; s += (v[j].x * v[j].x + v[j].y * v[j].y) + (v[j].z * v[j].z + v[j].w * v[j].w); }
    const float rstd = 1.f / sqrtf(wave_sum(s) * (1.f / 1024.f) + 1e-6f);
    v2u* o8 = (v2u*)orow + lane;
#pragma unroll
    for (int j = 0; j < 4; ++j) { const f32x4 y = v[j] * rstd * gr[64 * j]; v2u w; w.x = pk2(y.x, y.y); w.y = pk2(y.z, y.w); o8[64 * j] = w;
        if (orow8) { int q = 0; q = __builtin_amdgcn_cvt_pk_fp8_f32(y.x, y.y, q, false); q = __builtin_amdgcn_cvt_pk_fp8_f32(y.z, y.w, q, true); ((unsigned*)orow8)[lane + 64 * j] = (unsigned)q; } }
}
#define RLX_AGENT __ATOMIC_RELAXED, __HIP_MEMORY_SCOPE_AGENT
#define XB_TMO      128
#define XB_XCNT(j)  (256  + 64 * (j))
#define XB_XSUB(j)  (1280 + 64 * (j))
#define XB_XGEN(j)  (2304 + 64 * (j))
#define XB_TOP      3328
#define XB_TOPGEN   3392
#define XCD_BAR_WORDS 3456
#define XB_SPIN_CAP (1u << 18)

__device__ __forceinline__ unsigned xb_ld(unsigned* p)              { return __hip_atomic_load(p, __ATOMIC_RELAXED, __HIP_MEMORY_SCOPE_AGENT); }
__device__ __forceinline__ unsigned xb_add(unsigned* p, unsigned v) { return __hip_atomic_fetch_add(p, v, __ATOMIC_RELAXED, __HIP_MEMORY_SCOPE_AGENT); }
__device__ __forceinline__ unsigned xb_xcc_id() { return (unsigned)__builtin_amdgcn_s_getreg((3 << 11) | 20) & 0xFu; }
#define XB_SPIN(cond, bar) do { unsigned _sp = 0; while (cond) { __builtin_amdgcn_s_sleep(1); \
    if ((++_sp & 255u) == 0u) { if (xb_ld(&(bar)[XB_TMO])) break; if (_sp > XB_SPIN_CAP) { atomicAdd(&(bar)[XB_TMO], 1u); break; } } } } while (0)

struct XcdBarrier {
    unsigned* bar; unsigned x;
    volatile LAS unsigned* st;
};

__device__ __forceinline__ XcdBarrier xcd_barrier_post(unsigned* bar, volatile LAS unsigned* st, bool t0) {
    XcdBarrier b; b.bar = bar; b.x = xb_xcc_id(); b.st = st;
    if (t0) (void)xb_add(&bar[XB_XCNT(b.x)], 1u);
    return b;
}
__device__ __forceinline__ void xcd_barrier_complete(unsigned* bar, unsigned x, unsigned& nloc, unsigned& nx) {
    const unsigned G = gridDim.x * gridDim.y * gridDim.z;
    unsigned sum, cnt, mine, sp = 0u;
    for (;;) {
        sum = 0u; cnt = 0u; mine = 0u;
#pragma unroll
        for (unsigned j = 0; j < 16; ++j) { const unsigned c = xb_ld(&bar[XB_XCNT(j)]); sum += c; cnt += (c > 0u) ? 1u : 0u; mine = (j == x) ? c : mine; }
        if (sum == G) break;
        __builtin_amdgcn_s_sleep(1);
        if ((++sp & 255u) == 0u) { if (xb_ld(&bar[XB_TMO])) break; if (sp > XB_SPIN_CAP) { atomicAdd(&bar[XB_TMO], 1u); break; } }
    }
    nloc = mine > 0u ? mine : 1u; nx = cnt > 0u ? cnt : 1u;
}

__device__ __forceinline__ void xcd_barrier(const XcdBarrier& b, bool t0) {
    asm volatile("s_waitcnt vmcnt(0)" ::: "memory");
    __syncthreads();
    if (t0) {
        unsigned* bar = b.bar;
        __builtin_amdgcn_s_waitcnt(0);
        unsigned nloc = b.st[0], nx = b.st[1];
        if (nloc == 0u) { xcd_barrier_complete(bar, b.x, nloc, nx); b.st[0] = nloc; b.st[1] = nx; }
        const unsigned old = xb_add(&bar[XB_XSUB(b.x)], 1u);
        const unsigned gen = old / nloc;
        if (old + 1u == (gen + 1u) * nloc) {
            __builtin_amdgcn_fence(__ATOMIC_RELEASE, "agent");
            asm volatile("s_waitcnt vmcnt(0)" ::: "memory");
            const unsigned og = xb_add(&bar[XB_TOP], 1u);
            const unsigned tg = og / nx;
            if (og + 1u == (tg + 1u) * nx) xb_add(&bar[XB_TOPGEN], 1u);
            else XB_SPIN(xb_ld(&bar[XB_TOPGEN]) == tg, bar);
            __builtin_amdgcn_fence(__ATOMIC_ACQUIRE, "agent");
            xb_add(&bar[XB_XGEN(b.x)], 1u);
            asm volatile("s_waitcnt vmcnt(0)" ::: "memory");
        } else {
            XB_SPIN(xb_ld(&bar[XB_XGEN(b.x)]) == gen, bar);
            __builtin_amdgcn_fence(__ATOMIC_ACQUIRE, "agent");
            asm volatile("s_waitcnt vmcnt(0)" ::: "memory");
        }
    }
    __syncthreads();
}

constexpr size_t WS_CTL = 0, CTL_ZERO_BYTES = 65536; constexpr int CW_BAR = 1024;
constexpr int LDSCTL_OFF = RING_BYTES, MISC_OFF = LDSCTL_OFF + 320;
#define LANE_ID() ((int)__builtin_amdgcn_mbcnt_hi(~0u, __builtin_amdgcn_mbcnt_lo(~0u, 0u)))
struct Args { const float *x, *meta, *norm_g, *w_in, *conv_w, *conv_b, *cn_g, *cn_b, *w_conv_out, *q_g, *k_g, *w_attn_out, *w_out; float* out; unsigned char* ws; int ph_lo, ph_hi; };

__device__ __forceinline__ void p0_prologue(const Args& a, LAS unsigned char* lds, int vcu, int G, int tid, int lane, int wave) {
    unsigned char* ws = a.ws;
    LAS float* scr = (LAS float*)(lds + wave * 16384);
    const int gw = vcu * NWAVES + wave, NGW = G * NWAVES;
    constexpr int I_IN = (DMODEL / 64) * (NIN / 32), I_SQ = (DMODEL / 64) * (DMODEL / 32), NITEMS = I_IN + 3 * I_SQ;
    for (int it = gw; it < NITEMS; it += NGW) {
        int r = it;
        if (r < I_IN) { p0_transpose_item<true>(a.w_in, DMODEL, NIN, (bf16*)(ws + WS_WIN), DMODEL, (unsigned char*)a.out + OUT_W8, scr, r, lane); continue; } r -= I_IN;
        if (r < I_SQ) { p0_transpose_item<false>(a.w_conv_out, DMODEL, DMODEL, (bf16*)(ws + WS_WC), 2 * DMODEL, nullptr, scr, r, lane); continue; } r -= I_SQ;
        if (r < I_SQ) { p0_transpose_item<false>(a.w_attn_out, DMODEL, DMODEL, (bf16*)(ws + WS_WC) + DMODEL, 2 * DMODEL, nullptr, scr, r, lane); continue; } r -= I_SQ;
        p0_transpose_item<false>(a.w_out, DMODEL, DMODEL, (bf16*)(ws + WS_WO), DMODEL, nullptr, scr, r, lane);
    }
    bf16* XN = (bf16*)(ws + WS_XN); unsigned char* XN8 = (unsigned char*)a.out + OUT_XN8;
    int m = gw;
    for (; m + NGW < MR; m += 2 * NGW) {
        const int m1 = m + NGW;
        const f32x4* x0 = (const f32x4*)(a.x + (size_t)m * DMODEL) + lane; const f32x4* x1 = (const f32x4*)(a.x + (size_t)m1 * DMODEL) + lane; const f32x4* gr = (const f32x4*)a.norm_g + lane;
        f32x4 v0[4], v1[4]; float s0 = 0.f, s1 = 0.f;
#pragma unroll
        for (int j = 0; j < 4; ++j) { v0[j] = x0[64 * j]; v1[j] = x1[64 * j]; }
#pragma unroll
        for (int j = 0; j < 4; ++j) { s0 += (v0[j].x * v0[j].x + v0[j].y * v0[j].y) + (v0[j].z * v0[j].z + v0[j].w * v0[j].w); s1 += (v1[j].x * v1[j].x + v1[j].y * v1[j].y) + (v1[j].z * v1[j].z + v1[j].w * v1[j].w); }
#pragma unroll
        for (int o = 1; o < 64; o <<= 1) { s0 += __shfl_xor(s0, o); s1 += __shfl_xor(s1, o); }
        const float r0 = 1.f / sqrtf(s0 * (1.f / 1024.f) + 1e-6f), r1 = 1.f / sqrtf(s1 * (1.f / 1024.f) + 1e-6f);
        v2u* o0 = (v2u*)(XN + (size_t)m * DMODEL) + lane; v2u* o1 = (v2u*)(XN + (size_t)m1 * DMODEL) + lane;
#pragma unroll
        for (int j = 0; j < 4; ++j) { const f32x4 gg = gr[64 * j]; const f32x4 y0 = v0[j] * r0 * gg, y1 = v1[j] * r1 * gg; v2u w0, w1; w0.x = pk2(y0.x, y0.y); w0.y = pk2(y0.z, y0.w); w1.x = pk2(y1.x, y1.y); w1.y = pk2(y1.z, y1.w); o0[64 * j] = w0; o1[64 * j] = w1;
            int q0 = 0, q1 = 0; q0 = __builtin_amdgcn_cvt_pk_fp8_f32(y0.x, y0.y, q0, false); q0 = __builtin_amdgcn_cvt_pk_fp8_f32(y0.z, y0.w, q0, true); q1 = __builtin_amdgcn_cvt_pk_fp8_f32(y1.x, y1.y, q1, false); q1 = __builtin_amdgcn_cvt_pk_fp8_f32(y1.z, y1.w, q1, true);
            ((unsigned*)(XN8 + (size_t)m * DMODEL))[lane + 64 * j] = (unsigned)q0; ((unsigned*)(XN8 + (size_t)m1 * DMODEL))[lane + 64 * j] = (unsigned)q1; }
    }
    for (; m < MR + 64; m += NGW) {
        if (m < MR) rms_row_to_bf16(a.x + (size_t)m * DMODEL, a.norm_g, XN + (size_t)m * DMODEL, XN8 + (size_t)m * DMODEL, lane);
        else if (m < MR + NMETA) rms_row_to_bf16(a.meta + (size_t)(m - MR) * DMODEL, a.norm_g, XN + (size_t)m * DMODEL, nullptr, lane);
        else { const v2u z = {0u, 0u};
            ((v2u*)((bf16*)(ws + WS_K) + (size_t)m * 256))[lane] = z; ((v2u*)((bf16*)(ws + WS_V) + (size_t)m * 256))[lane] = z; }
    }
    if (blockIdx.x == 0) {
        float* rope = (float*)(ws + WS_ROPE);
        for (int idx = tid; idx < 1024; idx += NWAVES * 64) { const int pos = idx >> 4, f = idx & 15;
            const float inv = __builtin_amdgcn_exp2f(-(float)f * (13.287712379549449f / 16.0f)); const float ang = (float)pos * inv;
            rope[idx] = __cosf(ang); rope[1024 + idx] = __sinf(ang); }
    }
}

__device__ __forceinline__ void conv_phase(unsigned char* ws, const Args& a, LAS unsigned char* lds, int vcu, int G, int tid, int lane, int wave) {
    const bf16* U = (const bf16*)(ws + WS_U); const bf16* SZ = (const bf16*)(ws + WS_SZ); bf16* C = (bf16*)a.out;
    const float* conv_w = a.conv_w; const float* conv_b = a.conv_b; const float* cn_g = a.cn_g; const float* cn_b = a.cn_b;
    const int NU = NBATCH * (SEQL / 32), upc = (NU + G - 1) / G, ch = 2 * tid;
    LAS float* tile = (LAS float*)lds;
    f32x2 w[31];
#pragma unroll
    for (int j = 0; j < 31; ++j) w[j] = *(const f32x2*)(conv_w + j * 1024 + ch);
    const f32x2 bias = *(const f32x2*)(conv_b + ch);
    for (int i = 0; i < upc; ++i) {
        const int id = vcu * upc + i; if (id >= NU) break;
        const int b = id >> 6, t0 = (id & 63) * 32;
        f32x2 acc[32];
#pragma unroll
        for (int o = 0; o < 32; ++o) acc[o] = bias;
        unsigned raw[3][8];
#define CONV_LOAD(g, dst, tie) do { int tb_ = t0 - 15 + 8 * (g); asm volatile("" : "+s"(tb_), "+v"(tie)); \
            _Pragma("unroll") for (int r = 0; r < 8; ++r) if (8 * (g) + r < 62) { const int tt = tb_ + r; \
                const int row = tt < 0 ? (MR + NMETA + tt) : (tt < SEQL ? b * SEQL + tt : b * SEQL + SEQL - 1); \
                dst[r] = *(const unsigned*)(U + (size_t)row * 1024 + ch); } } while (0)
        CONV_LOAD(0, raw[0], acc[0]); CONV_LOAD(1, raw[1], acc[0]);
#pragma unroll
        for (int g = 0; g < 8; ++g) {
            if (g + 2 < 8) { const int og = (8 * g - 8) < 0 ? 0 : ((8 * g - 8) > 31 ? 31 : (8 * g - 8)); CONV_LOAD(g + 2, raw[(g + 2) % 3], acc[og]); }
#pragma unroll
            for (int r = 0; r < 8; ++r) { const int ii = 8 * g + r; if (ii < 62) {
                const unsigned rw = raw[g % 3][r];
                f32x2 uv = {__uint_as_float(rw << 16), __uint_as_float(rw & 0xffff0000u)};
                if (t0 - 15 + ii >= SEQL) uv = (f32x2){0.f, 0.f};
#pragma unroll
                for (int o = 0; o < 32; ++o) { const int j = ii - o; if (j >= 0 && j <= 30) acc[o] += w[j] * uv; } } }
        }
#undef CONV_LOAD
#pragma unroll
        for (int o = 0; o < 32; ++o) *(LAS f32x2*)(tile + o * 1024 + ch) = acc[o];
        __syncthreads();
        {
            const size_t grow0 = (size_t)(b * SEQL + t0 + wave * 4) * 1024, crow0 = grow0 * 2;
            v2u zz[4][4];
#pragma unroll
            for (int k = 0; k < 4; ++k)
#pragma unroll
                for (int j = 0; j < 4; ++j) zz[k][j] = *(const v2u*)(SZ + grow0 + (size_t)k * 1024 + 4 * lane + 256 * j);
            f32x4 v[4][4]; float s[4];
#pragma unroll
            for (int k = 0; k < 4; ++k) { const LAS float* rp = tile + (wave * 4 + k) * 1024 + 4 * lane; s[k] = 0.f;
#pragma unroll
                for (int j = 0; j < 4; ++j) { v[k][j] = *(const LAS f32x4*)(rp + 256 * j); s[k] += (v[k][j].x + v[k][j].y) + (v[k][j].z + v[k][j].w); } }
#pragma unroll
            for (int o = 1; o < 64; o <<= 1)
#pragma unroll
                for (int k = 0; k < 4; ++k) s[k] += __shfl_xor(s[k], o);
            float s2[4];
#pragma unroll
            for (int k = 0; k < 4; ++k) { const float mean = s[k] * (1.f / 1024.f); s2[k] = 0.f;
#pragma unroll
                for (int j = 0; j < 4; ++j) { v[k][j] = v[k][j] - mean; s2[k] += (v[k][j].x * v[k][j].x + v[k][j].y * v[k][j].y) + (v[k][j].z * v[k][j].z + v[k][j].w * v[k][j].w); } }
#pragma unroll
            for (int o = 1; o < 64; o <<= 1)
#pragma unroll
                for (int k = 0; k < 4; ++k) s2[k] += __shfl_xor(s2[k], o);
#pragma unroll
            for (int j = 0; j < 4; ++j) { const int col = 4 * lane + 256 * j; const f32x4 g4 = *(const f32x4*)(cn_g + col), b4 = *(const f32x4*)(cn_b + col);
#pragma unroll
                for (int k = 0; k < 4; ++k) { const float rstd = 1.f / sqrtf(s2[k] * (1.f / 1024.f) + 1e-6f);
                    f32x4 y = v[k][j] * rstd * g4 + b4;
                    y = y * pg8::sigm4(y); y = y * pg8::bf_lo4(zz[k][j].x, zz[k][j].y);
                    v2u o; o.x = pk2(y.x, y.y); o.y = pk2(y.z, y.w); __builtin_nontemporal_store(o, (v2u*)(C + crow0 + (size_t)k * 2048 + col)); } }
        }
        __syncthreads();
    }
}

__device__ __forceinline__ void meta_proj(unsigned char* ws, const float* kg, LAS unsigned char* lds, int item, int wave, int lane) {
    typedef short bf16x8_t __attribute__((ext_vector_type(8)));
    const bf16* XN = (const bf16*)(ws + WS_XN); const bf16* WIN = (const bf16*)(ws + WS_WIN);
    bf16* U = (bf16*)(ws + WS_U); bf16* Kb = (bf16*)(ws + WS_K); bf16* Vb = (bf16*)(ws + WS_V);
    const int col = lane & 15, quad = lane >> 4;
    int nb[4]; int nblk;
    if (item < 64) { const int ch0 = 16 * item, pn = ch0 >> 7, j0 = ch0 & 127; nblk = 2; nb[0] = 256 * pn + j0; nb[1] = nb[0] + 128; nb[2] = nb[0]; nb[3] = nb[1]; }
    else if (item < 68) { const int hd = item - 64; nblk = 4; nb[0] = 4096 + 32 * hd; nb[1] = nb[0] + 16; nb[2] = nb[0] + 128; nb[3] = nb[2] + 16; }
    else { const int it = item - 68; nblk = 4; nb[0] = 4352 + 64 * it; nb[1] = nb[0] + 16; nb[2] = nb[0] + 32; nb[3] = nb[0] + 48; }
    f32x4 acc[4];
#pragma unroll
    for (int k = 0; k < 4; ++k) acc[k] = (f32x4){0.f, 0.f, 0.f, 0.f};
    const bf16* ap = XN + (size_t)(MR + col) * 1024 + 128 * wave + 8 * quad;
#pragma unroll
    for (int q = 0; q < 4; ++q) {
        const bf16x8_t av = *(const bf16x8_t*)(ap + 32 * q);
#pragma unroll
        for (int k = 0; k < 4; ++k) if (k < nblk) {
            const bf16x8_t bv = *(const bf16x8_t*)(WIN + (size_t)(nb[k] + col) * 1024 + 128 * wave + 32 * q + 8 * quad);
            acc[k] = __builtin_amdgcn_mfma_f32_16x16x32_bf16(av, bv, acc[k], 0, 0, 0); }
    }
    LAS f32x4* red = (LAS f32x4*)lds;
#pragma unroll
    for (int k = 0; k < 4; ++k) red[(wave * 4 + k) * 64 + lane] = acc[k];
    __syncthreads();
    if (wave == 0) {
#pragma unroll
        for (int k = 0; k < 4; ++k) { f32x4 s = red[k * 64 + lane];
#pragma unroll
            for (int w = 1; w < 8; ++w) s = s + red[(w * 4 + k) * 64 + lane];
            acc[k] = s; }
        if (item < 64) {
#pragma unroll
            for (int r = 0; r < 4; ++r) { const float u = acc[0][r] * pg8::sigm_f(acc[1][r]); U[(size_t)(MR + 4 * quad + r) * 1024 + 16 * item + col] = (bf16)(pk2(u, 0.f) & 0xffffu); }
        } else if (item < 68) {
            const int hd = item - 64;
#pragma unroll
            for (int r = 0; r < 4; ++r) { float ss = 0.f;
#pragma unroll
                for (int k = 0; k < 4; ++k) ss += acc[k][r] * acc[k][r];
                ss += __shfl_xor(ss, 1); ss += __shfl_xor(ss, 2); ss += __shfl_xor(ss, 4); ss += __shfl_xor(ss, 8);
                const float rstd = 1.0f / sqrtf(ss * (1.0f / 64.0f) + 1e-6f);
#pragma unroll
                for (int k = 0; k < 4; ++k) { const int bj = k >> 1, i32 = 16 * (k & 1) + col, dn = 32 * bj + 16 * ((i32 >> 2) & 1) + 4 * (i32 >> 3) + (i32 & 3);
                    const float v = acc[k][r] * rstd * kg[dn]; Kb[(size_t)(MR + 4 * quad + r) * 256 + hd * 64 + 32 * bj + i32] = (bf16)(pk2(v, 0.f) & 0xffffu); } }
        } else {
            const int it = item - 68;
#pragma unroll
            for (int r = 0; r < 4; ++r)
#pragma unroll
                for (int k = 0; k < 4; ++k) Vb[(size_t)(MR + 4 * quad + r) * 256 + 64 * it + 16 * k + col] = (bf16)(pk2(acc[k][r], 0.f) & 0xffffu);
        }
    }
    __syncthreads();
}

__global__ void __launch_bounds__(NWAVES * 64, 2) fwd_kernel(Args a) {
    extern __shared__ __attribute__((aligned(16))) unsigned char lds[];
    cg::grid_group grid = cg::this_grid();
    LAS unsigned char* l3 = (LAS unsigned char*)lds;
    const int wave = __builtin_amdgcn_readfirstlane(threadIdx.x >> 6);
#define GRID_SEAM() do { const bool t0_ = (wave == 0) && (LANE_ID() == 0); XcdBarrier xb_; xb_.bar = (unsigned*)(a.ws + WS_CTL) + CW_BAR; xb_.x = xb_xcc_id(); xb_.st = (volatile LAS unsigned*)(l3 + MISC_OFF) + 8; xcd_barrier(xb_, t0_); } while (0)
#define OPAQUE_WS() do { size_t z_ = 0; asm volatile("" : "+s"(z_)); ws = a.ws + z_; } while (0)
    const int G = gridDim.x, bx = blockIdx.x, vcu = (G % 8 == 0) ? (bx % 8) * (G / 8) + bx / 8 : bx;
    unsigned char* ws;
#define XN ((bf16*)(ws + WS_XN))
#define Ub ((bf16*)(ws + WS_U))
#define SZb ((bf16*)(ws + WS_SZ))
#define Qb ((bf16*)(ws + WS_Q))
#define SAZb ((bf16*)(ws + WS_SAZ))
#define GCSb ((bf16*)(ws + WS_GCS))
#define GASb ((bf16*)(ws + WS_GAS))
#define Kb ((bf16*)(ws + WS_K))
#define Vb ((bf16*)(ws + WS_V))
    for (int u = wave * 64 + LANE_ID(); u < (LDS_BYTES - LDSCTL_OFF) / 4; u += NWAVES * 64) ((LAS unsigned*)(l3 + LDSCTL_OFF))[u] = 0u;
    __syncthreads();
    (void)xcd_barrier_post((unsigned*)(a.ws + WS_CTL) + CW_BAR, (volatile LAS unsigned*)(l3 + MISC_OFF) + 8, (wave == 0) && (LANE_ID() == 0));
    if (a.ph_hi == 0x7fffffff) grid.sync();
#ifndef MK_REP_SYNC
#define MK_REP_SYNC 0
#endif
#define REP_SYNC() do { if (MK_REP_SYNC && rep_ > 0) GRID_SEAM(); } while (0)
#ifndef MK_REP_ATTN
#define MK_REP_ATTN 1
#endif
#ifndef MK_REP_SEAM
#define MK_REP_SEAM 1
#endif
#ifndef MK_REP_P0
#define MK_REP_P0 1
#endif
#ifndef MK_REP_P1
#define MK_REP_P1 1
#endif
#ifndef MK_REP_CONV
#define MK_REP_CONV 1
#endif
#ifndef MK_REP_P345
#define MK_REP_P345 1
#endif
#define IN(k) (a.ph_lo <= (k) && (k) < a.ph_hi)
#define SEAM(k) do { if (IN(k) && IN((k) + 1)) for (int rs_ = 0; rs_ < MK_REP_SEAM; ++rs_) GRID_SEAM(); OPAQUE_WS(); } while (0)
    OPAQUE_WS();
    if (IN(0)) for (int rep_ = 0; rep_ < MK_REP_P0; ++rep_) { const int lane = LANE_ID(), tid = wave * 64 + lane; p0_prologue(a, l3, vcu, G, tid, lane, wave); __syncthreads(); }
    SEAM(0);
    if (IN(1)) for (int rep_ = 0; rep_ < MK_REP_P1; ++rep_) { REP_SYNC();
        for (int item = bx; item < 72; item += G) { int lane = LANE_ID(); asm volatile("" : "+v"(lane)); meta_proj(ws, a.k_g, l3, item, wave, lane); }
        {
            pg8::Gemm g{(const bf16*)((const unsigned char*)a.out + OUT_XN8), (const bf16*)((const unsigned char*)a.out + OUT_W8), MR, 14 * 256, DMODEL / 2, DMODEL / 2}; pg8::RemapOrder S; S.base.init(MR, 14 * 256, G, bx); S.mode = 1;
            pg8::EpiIn<1> E{ws, a.q_g, a.k_g, WS_U, WS_SZ, WS_Q, WS_K, WS_V, WS_SAZ, WS_GCS, WS_GAS, WS_ROPE};
            pg8::gemm_phase<pg8::EpiIn<1>, pg8::RemapOrder, PG8_ALIGN, PG8_SP2, true>(l3, g, S, E, wave);
        }
        {
            pg8::Gemm g{XN, (const bf16*)(ws + WS_WIN), MR, 16 * 256, DMODEL, DMODEL}; pg8::RemapOrder S; S.base.init(MR, 16 * 256, G, bx); S.mode = 0;
            pg8::EpiIn<0> E{ws, a.q_g, a.k_g, WS_U, WS_SZ, WS_Q, WS_K, WS_V, WS_SAZ, WS_GCS, WS_GAS, WS_ROPE};
            pg8::gemm_phase<pg8::EpiIn<0>, pg8::RemapOrder, PG8_ALIGN, PG8_SP2, false>(l3, g, S, E, wave);
        }
    }
    SEAM(1);
    if (IN(2)) {
#pragma unroll 1
        for (int s_ = 0; s_ < 2; ++s_) {
            if ((s_ ^ (vcu & 1)) == 0) { int lane = LANE_ID(); asm volatile("" : "+v"(lane)); const int tid = wave * 64 + lane; conv_phase(ws, a, l3, vcu, G, tid, lane, wave); }
            else {
                const attn_body::AttnTensors AT{(const attn_body::bf16*)Qb, (const attn_body::bf16*)Kb, (const attn_body::bf16*)Vb, (attn_body::bf16*)a.out + DMODEL, (const attn_body::bf16*)SAZb};
                attn_body::attn_phase<8>((char*)lds, AT, vcu, G, wave);
            }
        }
    }
    SEAM(2);
    if (IN(3)) for (int rep_ = 0; rep_ < MK_REP_P345; ++rep_) { REP_SYNC();
        pg8::Gemm g{(const bf16*)a.out, (const bf16*)(ws + WS_WC), MR, DMODEL, DMODEL, 2 * DMODEL}; pg8::TwoPassOrder S; S.base.init(MR, DMODEL, G, bx); S.K = DMODEL;
        pg8::EpiMerge E{SZb, GCSb, GASb};
        pg8::gemm_phase<pg8::EpiMerge, pg8::TwoPassOrder, PG8_ALIGN, PG8_SP2>(l3, g, S, E, wave);
    }
    SEAM(3);
    if (IN(4)) for (int rep_ = 0; rep_ < MK_REP_P345; ++rep_) { REP_SYNC();
        pg8::Gemm g{SZb, (const bf16*)(ws + WS_WO), MR, DMODEL, DMODEL, DMODEL}; pg8::StaticOrder S; S.init(MR, DMODEL, G, bx);
        pg8::EpiOut E{a.x, a.out};
        pg8::gemm_phase<pg8::EpiOut, pg8::StaticOrder, PG8_ALIGN, PG8_SP2>(l3, g, S, E, wave);
    }
}

#ifdef MK_DIAG
__global__ void dump_k(const unsigned short* A, const unsigned short* B, float wa, float wb, float* o, int n) {
    int i = blockIdx.x * blockDim.x + threadIdx.x; if (i < n) o[i] = wa * __uint_as_float((unsigned)A[i] << 16) + wb * __uint_as_float((unsigned)B[i] << 16); }
#endif
extern "C" void kernel_launch(void* const* d_in, const int* in_sizes, int n_in, void* d_out, int out_size, void* d_ws, size_t ws_size, hipStream_t stream) {
    static int grid = 0;
    if (grid == 0) {
        if (n_in != 13 || out_size != MR * DMODEL || ws_size < WS_END) { fprintf(stderr, "kernel_launch: unexpected shapes (n_in %d, out %d, ws %zu)\n", n_in, out_size, ws_size); grid = -1; return; }
        int dev = 0, cus = 0, per_cu = 0;
        if (hipGetDevice(&dev) != hipSuccess || hipDeviceGetAttribute(&cus, hipDeviceAttributeMultiprocessorCount, dev) != hipSuccess) { grid = -1; return; }
        if (hipFuncSetAttribute((const void*)fwd_kernel, hipFuncAttributeMaxDynamicSharedMemorySize, LDS_BYTES) != hipSuccess) { fprintf(stderr, "kernel_launch: hipFuncSetAttribute failed\n"); grid = -1; return; }
        if (hipOccupancyMaxActiveBlocksPerMultiprocessor(&per_cu, (const void*)fwd_kernel, NWAVES * 64, LDS_BYTES) != hipSuccess || per_cu < 1) { fprintf(stderr, "kernel_launch: occupancy query says %d\n", per_cu); per_cu = 1; }
        (void)hipGetLastError();
        grid = cus;
    }
    if (grid < 0) return;
    Args a{};
    a.x = (const float*)d_in[0]; a.meta = (const float*)d_in[1]; a.norm_g = (const float*)d_in[2]; a.w_in = (const float*)d_in[3]; a.conv_w = (const float*)d_in[4]; a.conv_b = (const float*)d_in[5];
    a.cn_g = (const float*)d_in[6]; a.cn_b = (const float*)d_in[7]; a.w_conv_out = (const float*)d_in[8]; a.q_g = (const float*)d_in[9]; a.k_g = (const float*)d_in[10]; a.w_attn_out = (const float*)d_in[11];
    a.w_out = (const float*)d_in[12]; a.out = (float*)d_out; a.ws = (unsigned char*)d_ws;
#ifndef MK_N_LAUNCHES
#define MK_N_LAUNCHES 1
#endif
#ifdef MK_DIAG
    for (int li = 0; li < MK_DIAG; ++li) {
        a.ph_lo = li; a.ph_hi = li + 1; void* args[] = {&a};
        (void)hipLaunchCooperativeKernel((const void*)fwd_kernel, dim3(grid), dim3(NWAVES * 64), args, LDS_BYTES, stream);
    }
    dump_k<<<MR * DMODEL / 256, 256, 0, stream>>>((const unsigned short*)((char*)d_ws + MK_DIAG_A), (const unsigned short*)((char*)d_ws + MK_DIAG_B), MK_DIAG_WA, MK_DIAG_WB, (float*)d_out, MR * DMODEL);
    return;
#endif
    if (hipMemsetAsync((char*)d_ws + WS_CTL, 0, CTL_ZERO_BYTES, stream) != hipSuccess) { fprintf(stderr, "kernel_launch: hipMemsetAsync failed\n"); return; }
    for (int li = 0; li < MK_N_LAUNCHES; ++li) {
        a.ph_lo = (MK_N_LAUNCHES == 1) ? 0 : li; a.ph_hi = (MK_N_LAUNCHES == 1) ? 5 : li + 1;
        void* args[] = {&a};
        const hipError_t e = hipLaunchCooperativeKernel((const void*)fwd_kernel, dim3(grid), dim3(NWAVES * 64), args, LDS_BYTES, stream);
        if (e != hipSuccess) fprintf(stderr, "kernel_launch: cooperative launch failed: %s (grid %d)\n", hipGetErrorString(e), grid);
    }
}
```

```cpp
#include <hip/hip_runtime.h>
#include <cstdio>
#include <cstdint>
namespace pg8 {
#define PG8_LAS __attribute__((address_space(3)))
typedef unsigned short bf16_t;
typedef short bf16x8 __attribute__((ext_vector_type(8)));
typedef float f32x4 __attribute__((ext_vector_type(4)));
typedef unsigned u32x4 __attribute__((ext_vector_type(4)));
constexpr int BM = 256, BK = 64, HALF = 128, HTB = HALF * BK * 2  , STAGE_BYTES = 8 * HTB, NXCD = 8, WGM = 8;

__host__ __device__ __forceinline__ int lds_byte(int r, int c) { const int st = (r >> 4) * 2 + (c >> 5), rr = r & 15, cc = c & 31, ob = rr * 64 + cc * 2; return st * 1024 + (ob ^ (((ob >> 9) & 1) << 5)); }
__host__ __device__ __forceinline__ void stage_rc(int b, int& R, int& C) { const int st = b / 1024, sb = b % 1024, swz = sb ^ (((sb >> 9) & 1) << 5); R = (st >> 1) * 16 + swz / 64; C = (st & 1) * 32 + (swz % 64) / 2; }
__host__ __device__ __forceinline__ int perm32(int rho) { const int n = rho >> 4, i = rho & 15; return 8 * (i >> 2) + 4 * n + (i & 3); }

typedef int i32x4_t __attribute__((ext_vector_type(4))); typedef int i32x8_t __attribute__((ext_vector_type(8)));
constexpr int FP8_SCALE_A = 0x7f7f7f7f, FP8_SCALE_B = 0x79797979, FP8_SCALE_AB = 0x7f7f7979;
struct Unit { int pm, pn, kofs, pb; };
struct Gemm { const bf16_t* A; const bf16_t* Bt; int M, N, K, ld; };

struct StaticOrder {
    int nM, nN, nwg, G, c;
    __host__ __device__ void init(int M, int N, int G_, int c_) { nM = M / BM; nN = N / BM; nwg = nM * nN; G = G_; c = c_; }
    __host__ __device__ bool next(int i, Unit& u) const {
        const long L = (long)i * G + c; if (L >= nwg) return false;
        int wgid = (int)L; { const int q = nwg / NXCD, r = nwg % NXCD, xcd = wgid % NXCD, off = wgid / NXCD; wgid = (xcd < r ? xcd * (q + 1) : r * (q + 1) + (xcd - r) * q) + off; }
        const int nig = WGM * nN, gid = wgid / nig, fm = gid * WGM, gsz = (nM - fm) < WGM ? (nM - fm) : WGM;
        u.pm = fm + ((wgid % nig) % gsz); u.pn = (wgid % nig) / gsz; u.kofs = 0; u.pb = u.pn; return true;
    }
    __device__ __forceinline__ void a_ready(const Unit&) const {}
    __device__ __forceinline__ void done(const Unit&) const {}
};

typedef float f32x2c_t __attribute__((ext_vector_type(2))); typedef __bf16 bf16x2c_t __attribute__((ext_vector_type(2)));
__device__ __forceinline__ unsigned cvt_pk_bf16(float lo, float hi) { f32x2c_t v = {lo, hi}; bf16x2c_t b = __builtin_convertvector(v, bf16x2c_t); return __builtin_bit_cast(unsigned, b); }
typedef float f32x2 __attribute__((ext_vector_type(2)));
__device__ __forceinline__ f32x2 gelu_pk(f32x2 v) {
    const f32x2 av = __builtin_elementwise_abs(v), d = av * 0.2316418882f + 1.0f;
    f32x2 t; t.x = __builtin_amdgcn_rcpf(d.x); t.y = __builtin_amdgcn_rcpf(d.y);
    f32x2 q = t * 0.5307027145f + (-0.7265760135f); q = q * t + 0.7107068705f; q = q * t + (-0.142248368f); q = q * t + 0.127414796f; q = q * t;
    const f32x2 s = (v * v) * (-0.72134752044f);
    f32x2 e; e.x = __builtin_amdgcn_exp2f(s.x); e.y = __builtin_amdgcn_exp2f(s.y);
    const f32x2 m = v * (q * e), r = v - m;
    f32x2 o; o.x = v.x < 0.f ? m.x : r.x; o.y = v.y < 0.f ? m.y : r.y; return o;
}

template <int ACT  > struct EpiBf16 {
    static constexpr bool PERM = true, AFTER_DRAIN = false, HAS_MID = false; static_assert(ACT == 0 || ACT == 1, "EpiBf16: ACT is 0 (none) or 1 (gelu_pk)");
    bf16_t* O; int ldc; const float* bias; int split_cols; size_t split_stride; float scale0;
    __device__ __forceinline__ void operator()(const f32x4 (&acc)[2][2][4][2], const Unit& u, int wr, int wc, int fr, int fq) const {
        const int row0 = u.pm * BM + wr * 64 + fr; int colt = u.pn * BM; bf16_t* base = O;
        float sc = 1.f; if (split_cols) { const int t = colt / split_cols; base += (size_t)t * split_stride; colt -= t * split_cols; if (t == 0) sc = scale0; }
        const int col0 = colt + wc * 32 + 8 * fq, bcol0 = u.pn * BM + wc * 32 + 8 * fq;
        f32x4 bv[2][2];
#pragma unroll
        for (int bj = 0; bj < 2; ++bj)
#pragma unroll
            for (int n = 0; n < 2; ++n) bv[bj][n] = bias ? *(const f32x4*)(bias + bcol0 + bj * HALF + 4 * n) : (f32x4){0.f, 0.f, 0.f, 0.f};
#pragma unroll
        for (int ai = 0; ai < 2; ++ai)
#pragma unroll
            for (int m = 0; m < 4; ++m) { bf16_t* rowp = base + (size_t)(row0 + ai * HALF + m * 16) * ldc + col0;
#pragma unroll
                for (int bj = 0; bj < 2; ++bj) { f32x4 v0 = acc[ai][bj][m][0] + bv[bj][0], v1 = acc[ai][bj][m][1] + bv[bj][1];
                    if (ACT == 1) { f32x2 a = gelu_pk((f32x2){v0[0], v0[1]}), b = gelu_pk((f32x2){v0[2], v0[3]}), c = gelu_pk((f32x2){v1[0], v1[1]}), d = gelu_pk((f32x2){v1[2], v1[3]});
                        v0 = (f32x4){a.x, a.y, b.x, b.y}; v1 = (f32x4){c.x, c.y, d.x, d.y}; }
                    v0 = v0 * sc; v1 = v1 * sc; u32x4 w; w.x = cvt_pk_bf16(v0[0], v0[1]); w.y = cvt_pk_bf16(v0[2], v0[3]); w.z = cvt_pk_bf16(v1[0], v1[1]); w.w = cvt_pk_bf16(v1[2], v1[3]);
                    *(u32x4*)(rowp + bj * HALF) = w; } }
    }
};

struct RemapOrder {
    StaticOrder base; int mode;
    __host__ __device__ bool next(int i, Unit& u) const { if (!base.next(i, u)) return false; const int p = u.pn;
        if (mode == 0) { u.pn = p < 12 ? p : p + 10; u.pb = u.pn; } else { u.pn = p < 10 ? 12 + p : 16 + p; u.pb = p; } return true; }
    __device__ __forceinline__ void a_ready(const Unit&) const {}
    __device__ __forceinline__ void done(const Unit&) const {}
};
struct TwoPassOrder {
    StaticOrder base; int K;
    __host__ __device__ bool next(int i, Unit& u) const { if (!base.next(i >> 1, u)) return false; u.kofs = (i & 1) * K; return true; }
    __device__ __forceinline__ void a_ready(const Unit&) const {}
    __device__ __forceinline__ void done(const Unit&) const {}
};
__device__ __forceinline__ float sigm_f(float x) { return __builtin_amdgcn_rcpf(1.0f + __builtin_amdgcn_exp2f(-1.4426950408889634f * x)); }
__device__ __forceinline__ f32x4 sigm4(f32x4 v) { return (f32x4){sigm_f(v[0]), sigm_f(v[1]), sigm_f(v[2]), sigm_f(v[3])}; }
__device__ __forceinline__ u32x4 pack8(f32x4 v0, f32x4 v1) { u32x4 w; w.x = cvt_pk_bf16(v0[0], v0[1]); w.y = cvt_pk_bf16(v0[2], v0[3]); w.z = cvt_pk_bf16(v1[0], v1[1]); w.w = cvt_pk_bf16(v1[2], v1[3]); return w; }
__device__ __forceinline__ f32x4 bf_lo4(unsigned a, unsigned b) { return (f32x4){__uint_as_float(a << 16), __uint_as_float(a & 0xffff0000u), __uint_as_float(b << 16), __uint_as_float(b & 0xffff0000u)}; }

template <int SIDE  > struct EpiIn {
    static constexpr bool PERM = true, AFTER_DRAIN = false, HAS_MID = false;
    unsigned char* ws; const float* qg; const float* kg;
    size_t oU, oSZ, oQ, oK, oV, oSAZ, oGCS, oGAS, oROPE;
    template <int ACT> __device__ __forceinline__ void act_store(const f32x4 (&acc)[2][2][4][2], bf16_t* base, int ldc, int colt, int row0, int wc, int fq) const {
        const int col0 = colt + wc * 32 + 8 * fq;
#pragma unroll
        for (int ai = 0; ai < 2; ++ai)
#pragma unroll
            for (int m = 0; m < 4; ++m) { bf16_t* rowp = base + (size_t)(row0 + ai * HALF + m * 16) * ldc + col0;
#pragma unroll
                for (int bj = 0; bj < 2; ++bj) { f32x4 v0 = acc[ai][bj][m][0], v1 = acc[ai][bj][m][1];
                    if (ACT == 1) { v0 = v0 * sigm4(v0); v1 = v1 * sigm4(v1); }
                    if (ACT == 2) { v0 = sigm4(v0); v1 = sigm4(v1); }
                    __builtin_nontemporal_store(pack8(v0, v1), (u32x4*)(rowp + bj * HALF)); } }
    }
    __device__ __forceinline__ void qk_store(bool ISQ, const f32x4 (&acc)[2][2][4][2], bf16_t* base, int ldc, int head, int row0, int fq) const {
        size_t z_ = 0; asm volatile("" : "+s"(z_));
        const float* g = (ISQ ? qg : kg) + z_; const float* rope = (const float*)(ws + oROPE) + z_;
        const float osc = ISQ ? 0.125f * 1.4426950408889634f : 1.0f;
#pragma unroll
        for (int ai = 0; ai < 2; ++ai)
#pragma unroll
            for (int m = 0; m < 4; ++m) {
                const int row = row0 + ai * HALF + m * 16;
                const int t = row & 2047; const bool real = row < 32768; const int rid = real ? (t >> 6) : 0, cid = real ? (t & 63) : 0;
                float ss = 0.f;
#pragma unroll
                for (int bj = 0; bj < 2; ++bj)
#pragma unroll
                    for (int n = 0; n < 2; ++n) { const f32x4 x = acc[ai][bj][m][n]; ss += (x[0] * x[0] + x[1] * x[1]) + (x[2] * x[2] + x[3] * x[3]); }
                ss += __int_as_float(__builtin_amdgcn_ds_swizzle(__float_as_int(ss), 0x401F));
                { auto rr = __builtin_amdgcn_permlane32_swap(__float_as_uint(ss), __float_as_uint(ss), false, false); ss = __uint_as_float(rr[0]) + __uint_as_float(rr[1]); }
                const float rstd = osc / sqrtf(ss * (1.0f / 64.0f) + 1e-6f);
                bf16_t* rowp = base + (size_t)row * ldc + head * 64 + 8 * fq;
#pragma unroll
                for (int bj = 0; bj < 2; ++bj) {
                    const int pos = bj ? cid : rid;
                    const f32x4 c = *(const f32x4*)(rope + pos * 16 + 4 * fq), s = *(const f32x4*)(rope + 1024 + pos * 16 + 4 * fq);
                    const f32x4 g0 = *(const f32x4*)(g + 32 * bj + 4 * fq), g1 = *(const f32x4*)(g + 32 * bj + 16 + 4 * fq);
                    const f32x4 xa = acc[ai][bj][m][0] * rstd * g0, xb = acc[ai][bj][m][1] * rstd * g1;
                    const f32x4 o0 = xa * c - xb * s, o1 = xb * c + xa * s;
                    __builtin_nontemporal_store(pack8(o0, o1), (u32x4*)(rowp + bj * 32)); asm volatile("" ::: "memory"); }
            }
    }
    __device__ __forceinline__ void operator()(const f32x4 (&acc)[2][2][4][2], const Unit& u, int wr, int wc, int fr_, int fq_) const {
        int fr = fr_, fq = fq_; asm volatile("" : "+v"(fr), "+v"(fq));
        const int pn = u.pn, row0 = u.pm * BM + wr * 64 + fr;
        if constexpr (SIDE == 0) {
        if (pn < 8) {
            const int col0 = pn * 128 + wc * 32 + 8 * fq;
#pragma unroll
            for (int ai = 0; ai < 2; ++ai)
#pragma unroll
                for (int m = 0; m < 4; ++m) {
                    const f32x4 v0 = acc[ai][0][m][0] * sigm4(acc[ai][1][m][0]), v1 = acc[ai][0][m][1] * sigm4(acc[ai][1][m][1]);
                    __builtin_nontemporal_store(pack8(v0, v1), (u32x4*)((bf16_t*)(ws + oU) + (size_t)(row0 + ai * HALF + m * 16) * 1024 + col0)); }
        }
        else if (pn < 12) act_store<1>(acc, (bf16_t*)(ws + oSZ), 1024, (pn - 8) * 256, row0, wc, fq);
        else act_store<2>(acc, (bf16_t*)(ws + oGCS), 1024, (pn - 22) * 256, row0, wc, fq);
        } else {
        if (pn <= 16) { const bool isq = pn < 16; qk_store(isq, acc, (bf16_t*)(ws + (isq ? oQ : oK)), isq ? 1024 : 256, isq ? (pn - 12) * 4 + wc : wc, row0, fq); }
        else if (pn == 17) act_store<0>(acc, (bf16_t*)(ws + oV), 256, 0, row0, wc, fq);
        else if (pn < 22) act_store<1>(acc, (bf16_t*)(ws + oSAZ), 1024, (pn - 18) * 256, row0, wc, fq);
        else act_store<2>(acc, (bf16_t*)(ws + oGAS), 1024, (pn - 26) * 256, row0, wc, fq);
        }
    }
};
template <int MODE> struct EpiGate {
    static constexpr bool PERM = true, AFTER_DRAIN = false, HAS_MID = false;
    bf16_t* O; const bf16_t* G; const bf16_t* Tin;
    __device__ __forceinline__ void operator()(const f32x4 (&acc)[2][2][4][2], const Unit& u, int wr, int wc, int fr, int fq) const {
        const int row0 = u.pm * BM + wr * 64 + fr, col0 = u.pn * BM + wc * 32 + 8 * fq;
#pragma unroll
        for (int ai = 0; ai < 2; ++ai)
#pragma unroll
            for (int m = 0; m < 4; ++m) { const size_t off = (size_t)(row0 + ai * HALF + m * 16) * 1024 + col0;
#pragma unroll
                for (int bj = 0; bj < 2; ++bj) {
                    const u32x4 gw = *(const u32x4*)(G + off + bj * HALF);
                    f32x4 v0 = acc[ai][bj][m][0] * bf_lo4(gw.x, gw.y), v1 = acc[ai][bj][m][1] * bf_lo4(gw.z, gw.w);
                    if (MODE == 1) { const u32x4 tw = *(const u32x4*)(Tin + off + bj * HALF); v0 = v0 + bf_lo4(tw.x, tw.y); v1 = v1 + bf_lo4(tw.z, tw.w); }
                    *(u32x4*)(O + off + bj * HALF) = pack8(v0, v1); } }
    }
};
struct EpiOut {
    static constexpr bool PERM = true, AFTER_DRAIN = false, HAS_MID = false;
    const float* X; float* O;
    __device__ __forceinline__ void operator()(const f32x4 (&acc)[2][2][4][2], const Unit& u, int wr, int wc, int fr, int fq) const {
        const int row0 = u.pm * BM + wr * 64 + fr, col0 = u.pn * BM + wc * 32 + 8 * fq;
#pragma unroll
        for (int ai = 0; ai < 2; ++ai)
#pragma unroll
            for (int m = 0; m < 4; ++m) { const size_t off = (size_t)(row0 + ai * HALF + m * 16) * 1024 + col0;
#pragma unroll
                for (int bj = 0; bj < 2; ++bj) {
                    const f32x4 x0 = *(const f32x4*)(X + off + bj * HALF), x1 = *(const f32x4*)(X + off + bj * HALF + 4);
                    *(f32x4*)(O + off + bj * HALF) = x0 + acc[ai][bj][m][0]; *(f32x4*)(O + off + bj * HALF + 4) = x1 + acc[ai][bj][m][1]; } }
    }
};
struct EpiMerge {
    static constexpr bool PERM = true, AFTER_DRAIN = false, HAS_MID = true;
    bf16_t* O; const bf16_t* GC; const bf16_t* GA;
    __device__ __forceinline__ void mid(f32x4 (&acc)[2][2][4][2], const Unit& u, int wr, int wc, int fr, int fq) const {
        const int row0 = u.pm * BM + wr * 64 + fr, col0 = u.pn * BM + wc * 32 + 8 * fq;
#pragma unroll
        for (int ai = 0; ai < 2; ++ai)
#pragma unroll
            for (int m = 0; m < 4; ++m) { const size_t off = (size_t)(row0 + ai * HALF + m * 16) * 1024 + col0;
#pragma unroll
                for (int bj = 0; bj < 2; ++bj) {
                    const u32x4 gc = *(const u32x4*)(GC + off + bj * HALF), ga = *(const u32x4*)(GA + off + bj * HALF);
                    const f32x4 a0 = bf_lo4(ga.x, ga.y), a1 = bf_lo4(ga.z, ga.w), c0 = bf_lo4(gc.x, gc.y), c1 = bf_lo4(gc.z, gc.w);
#pragma unroll
                    for (int e = 0; e < 4; ++e) { acc[ai][bj][m][0][e] *= c0[e] * __builtin_amdgcn_rcpf(fmaxf(a0[e], 1e-30f)); acc[ai][bj][m][1][e] *= c1[e] * __builtin_amdgcn_rcpf(fmaxf(a1[e], 1e-30f));     }
                    } }
    }
    __device__ __forceinline__ void two_pass(f32x4 (&acc)[2][2][4][2], const Unit& u, int wr, int wc, int fr, int fq) const { if (u.kofs == 0) mid(acc, u, wr, wc, fr, fq); else fin(acc, u, wr, wc, fr, fq); }
    __device__ __forceinline__ void fin(const f32x4 (&acc)[2][2][4][2], const Unit& u, int wr, int wc, int fr, int fq) const {
        const int row0 = u.pm * BM + wr * 64 + fr, col0 = u.pn * BM + wc * 32 + 8 * fq;
#pragma unroll
        for (int ai = 0; ai < 2; ++ai)
#pragma unroll
            for (int m = 0; m < 4; ++m) { const size_t off = (size_t)(row0 + ai * HALF + m * 16) * 1024 + col0;
#pragma unroll
                for (int bj = 0; bj < 2; ++bj) {
                    const u32x4 ga = *(const u32x4*)(GA + off + bj * HALF);
                    __builtin_nontemporal_store(pack8(acc[ai][bj][m][0] * bf_lo4(ga.x, ga.y), acc[ai][bj][m][1] * bf_lo4(ga.z, ga.w)), (u32x4*)(O + off + bj * HALF)); } }
    }
};

template <class Epi, class Sched, bool ALIGN_EPI = false, bool SP2 = false, bool FP8 = false>
__device__ __forceinline__ void gemm_phase(PG8_LAS unsigned char* lds, const Gemm g, const Sched& S, const Epi& E, int wave_id) {
    unsigned zl_ = 0u; asm volatile("" : "+s"(zl_));
    int lane_ = (int)__builtin_amdgcn_mbcnt_hi(~0u, __builtin_amdgcn_mbcnt_lo(~0u, zl_));
    const int wid = wave_id, wr = wid >> 2, wc = wid & 3;
    int nt_ = g.K / BK; asm volatile("" : "+s"(nt_));
    const int K = g.ld, nt = nt_;
    unsigned voffA[2], voffB[2]; int aoff, boff, fr, fq;
#define PG8_LANE_SETUP() do { asm volatile("" : "+v"(lane_)); const int tid_ = wid * 64 + lane_; fr = lane_ & 15; fq = lane_ >> 4; \
        _Pragma("unroll") for (int i = 0; i < 2; ++i) { int R, C; stage_rc(tid_ * 16 + i * 8192, R, C); const int Rb = Epi::PERM ? ((R & ~31) + perm32(R & 31)) : R; \
            voffA[i] = (unsigned)(R * K + C) * 2u; voffB[i] = (unsigned)(Rb * K + C) * 2u; } \
        aoff = lds_byte(wr * 64 + fr, fq * 8); boff = lds_byte(wc * 32 + fr, fq * 8); } while (0)
    PG8_LANE_SETUP();
    const size_t kstep = (size_t)(BK * 2);
    const size_t hstep = (size_t)HALF * K * 2;
    const size_t tstep = 2 * hstep;
    const unsigned ldsw = (unsigned)wid * 1024u;
#define PG8_SA(b, h) (((b) * 2 + (h)) * HTB)
#define PG8_SB(b, h) ((4 + (b) * 2 + (h)) * HTB)
#define PG8_STAGE(bufoff, gbase, voff) do { const unsigned long long gb_ = (unsigned long long)(gbase); \
        const char* sb_ = (const char*)(((unsigned long long)(unsigned)__builtin_amdgcn_readfirstlane((int)(gb_ >> 32)) << 32) | (unsigned long long)(unsigned)__builtin_amdgcn_readfirstlane((int)gb_));     \
        _Pragma("unroll") for (int _i = 0; _i < 2; ++_i) \
        __builtin_amdgcn_global_load_lds((const unsigned*)(sb_ + (voff)[_i]), (PG8_LAS unsigned*)(lds + (bufoff) + ldsw + _i * 8192), 16, 0, 0); } while (0)
#define PG8_LDA(dst, b, h) do { _Pragma("unroll") for (int m = 0; m < 4; ++m) _Pragma("unroll") for (int k = 0; k < 2; ++k) dst[m][k] = *(const PG8_LAS bf16x8*)(lds + PG8_SA(b, h) + aoff + m * 2048 + k * 1024); } while (0)
#define PG8_LDB(dst, b, h) do { _Pragma("unroll") for (int n = 0; n < 2; ++n) _Pragma("unroll") for (int k = 0; k < 2; ++k) dst[n][k] = *(const PG8_LAS bf16x8*)(lds + PG8_SB(b, h) + boff + n * 2048 + k * 1024); } while (0)
#define PG8_CAT(v) __builtin_shufflevector(__builtin_bit_cast(i32x4_t, v[0]), __builtin_bit_cast(i32x4_t, v[1]), 0, 1, 2, 3, 4, 5, 6, 7)
#define PG8_MMA(ai, bj, At, Bt) do { __builtin_amdgcn_s_setprio(1); \
        if constexpr (FP8) { _Pragma("unroll") for (int m = 0; m < 4; ++m) _Pragma("unroll") for (int n = 0; n < 2; ++n) \
            acc[ai][bj][m][n] = __builtin_amdgcn_mfma_scale_f32_16x16x128_f8f6f4(PG8_CAT(Bt[n]), PG8_CAT(At[m]), acc[ai][bj][m][n], 0, 0, 0, FP8_SCALE_AB, 2, FP8_SCALE_AB); } \
        else { _Pragma("unroll") for (int m = 0; m < 4; ++m) _Pragma("unroll") for (int n = 0; n < 2; ++n) _Pragma("unroll") for (int k = 0; k < 2; ++k) \
        acc[ai][bj][m][n] = __builtin_amdgcn_mfma_f32_16x16x32_bf16(Bt[n][k], At[m][k], acc[ai][bj][m][n], 0, 0, 0); } __builtin_amdgcn_s_setprio(0); } while (0)
#define PG8_WAIT_V(n) asm volatile("s_waitcnt vmcnt(" #n ")" ::: "memory")
#define PG8_WAIT_L(n) asm volatile("s_waitcnt lgkmcnt(" #n ")" ::: "memory")
#define PG8_BAR __builtin_amdgcn_s_barrier()
#define PG8_SCHED __builtin_amdgcn_sched_barrier(0)
    Unit cur, nxt; int ui = 0;
    if (!S.next(0, cur)) return;
    f32x4 acc[2][2][4][2];
#pragma unroll
    for (int a = 0; a < 2; ++a)
#pragma unroll
        for (int b = 0; b < 2; ++b)
#pragma unroll
            for (int m = 0; m < 4; ++m)
#pragma unroll
                for (int n = 0; n < 2; ++n) acc[a][b][m][n] = (f32x4){0.f, 0.f, 0.f, 0.f};
    bf16x8 At[4][2], B0[2][2], B1[2][2];
    const char* cA = (const char*)g.A + (size_t)cur.pm * tstep + (size_t)cur.kofs * 2; const char* cB = (const char*)g.Bt + (size_t)cur.pb * tstep + (size_t)cur.kofs * 2;
    S.a_ready(cur);
    if constexpr (SP2) {
        PG8_STAGE(PG8_SB(0, 0), cB, voffB); PG8_STAGE(PG8_SB(0, 1), cB + hstep, voffB); PG8_STAGE(PG8_SA(0, 0), cA, voffA); PG8_STAGE(PG8_SA(0, 1), cA + hstep, voffA);
        if (wr == 1) PG8_BAR;
        PG8_WAIT_V(2); PG8_BAR;
        PG8_STAGE(PG8_SB(1, 0), cB + kstep, voffB); PG8_STAGE(PG8_SA(1, 0), cA + kstep, voffA); PG8_STAGE(PG8_SB(1, 1), cB + hstep + kstep, voffB);
        PG8_WAIT_V(6); PG8_BAR;
    } else {
        PG8_STAGE(PG8_SB(0, 0), cB, voffB); PG8_STAGE(PG8_SA(0, 0), cA, voffA); PG8_STAGE(PG8_SB(0, 1), cB + hstep, voffB); PG8_STAGE(PG8_SA(0, 1), cA + hstep, voffA);
        if (wr == 1) PG8_BAR;
        PG8_WAIT_V(4); PG8_BAR;
        PG8_STAGE(PG8_SB(1, 0), cB + kstep, voffB); PG8_STAGE(PG8_SA(1, 0), cA + kstep, voffA); PG8_STAGE(PG8_SB(1, 1), cB + hstep + kstep, voffB);
        PG8_WAIT_V(6); PG8_BAR;
    }
    for (;;) {
        const bool has_next = S.next(ui + 1, nxt);
        const char* nA = has_next ? (const char*)g.A + (size_t)nxt.pm * tstep + (size_t)nxt.kofs * 2 : cA; const char* nB = has_next ? (const char*)g.Bt + (size_t)nxt.pb * tstep + (size_t)nxt.kofs * 2 : cB;
        for (int t = 0; t < nt; t += 2) {
            const bool last = (t == nt - 2);
            const char* a1 = cA + (size_t)(t + 1) * kstep;
            const char* a2 = last ? nA : cA + (size_t)(t + 2) * kstep; const char* b2 = last ? nB : cB + (size_t)(t + 2) * kstep;
            const char* a3 = a2 + kstep; const char* b3 = b2 + kstep;
            if (last && has_next) S.a_ready(nxt);
            if constexpr (SP2) {
            PG8_LDB(B0, 0, 0); PG8_LDB(B1, 0, 1); PG8_SCHED; PG8_LDA(At, 0, 0); PG8_STAGE(PG8_SA(1, 1), a1 + hstep, voffA);
            PG8_WAIT_V(8); PG8_WAIT_L(0); PG8_BAR; PG8_MMA(0, 0, At, B0); PG8_MMA(0, 1, At, B1); PG8_BAR; PG8_SCHED;
            PG8_LDA(At, 0, 1); PG8_STAGE(PG8_SB(0, 0), b2, voffB); PG8_STAGE(PG8_SB(0, 1), b2 + hstep, voffB); PG8_STAGE(PG8_SA(0, 0), a2, voffA);
            PG8_WAIT_V(8); PG8_WAIT_L(0); PG8_BAR; PG8_MMA(1, 0, At, B0); PG8_MMA(1, 1, At, B1); PG8_BAR; PG8_SCHED;
            PG8_LDB(B0, 1, 0); PG8_LDB(B1, 1, 1); PG8_SCHED; PG8_LDA(At, 1, 0); PG8_STAGE(PG8_SA(0, 1), a2 + hstep, voffA);
            PG8_WAIT_V(8); PG8_WAIT_L(0); PG8_BAR; PG8_MMA(0, 0, At, B0); PG8_MMA(0, 1, At, B1); PG8_BAR; PG8_SCHED;
            PG8_LDA(At, 1, 1); PG8_STAGE(PG8_SB(1, 0), b3, voffB); PG8_STAGE(PG8_SB(1, 1), b3 + hstep, voffB); PG8_STAGE(PG8_SA(1, 0), a3, voffA);
            PG8_WAIT_V(8); PG8_WAIT_L(0); PG8_BAR; PG8_MMA(1, 0, At, B0); PG8_MMA(1, 1, At, B1); PG8_BAR; PG8_SCHED;
            } else {
            PG8_LDB(B0, 0, 0); PG8_SCHED; PG8_LDA(At, 0, 0); PG8_STAGE(PG8_SA(1, 1), a1 + hstep, voffA);
            PG8_WAIT_L(8); PG8_BAR; PG8_WAIT_L(0); PG8_MMA(0, 0, At, B0); PG8_BAR; PG8_SCHED;
            PG8_LDB(B1, 0, 1); PG8_STAGE(PG8_SB(0, 0), b2, voffB);
            PG8_BAR; PG8_WAIT_L(0); PG8_MMA(0, 1, At, B1); PG8_BAR;
            PG8_LDA(At, 0, 1); PG8_STAGE(PG8_SA(0, 0), a2, voffA);
            PG8_BAR; PG8_WAIT_L(0); PG8_MMA(1, 0, At, B0); PG8_BAR; PG8_SCHED;
            PG8_STAGE(PG8_SB(0, 1), b2 + hstep, voffB);
            PG8_WAIT_V(6); PG8_BAR; PG8_MMA(1, 1, At, B1); PG8_BAR;
            PG8_LDB(B0, 1, 0); PG8_SCHED; PG8_LDA(At, 1, 0); PG8_STAGE(PG8_SA(0, 1), a2 + hstep, voffA);
            PG8_WAIT_L(8); PG8_BAR; PG8_WAIT_L(0); PG8_MMA(0, 0, At, B0); PG8_BAR; PG8_SCHED;
            PG8_LDB(B1, 1, 1); PG8_STAGE(PG8_SB(1, 0), b3, voffB);
            PG8_BAR; PG8_WAIT_L(0); PG8_MMA(0, 1, At, B1); PG8_BAR;
            PG8_LDA(At, 1, 1); PG8_STAGE(PG8_SA(1, 0), a3, voffA);
            PG8_BAR; PG8_WAIT_L(0); PG8_MMA(1, 0, At, B0); PG8_BAR; PG8_SCHED;
            PG8_STAGE(PG8_SB(1, 1), b3 + hstep, voffB);
            PG8_WAIT_V(6); PG8_BAR; PG8_MMA(1, 1, At, B1); PG8_BAR;
            }
        }
        if constexpr (ALIGN_EPI) { if (wr == 0) PG8_BAR; }
        if constexpr (Epi::HAS_MID) { E.two_pass(acc, cur, wr, wc, fr, fq); } else
        if constexpr (!Epi::AFTER_DRAIN) { E(acc, cur, wr, wc, fr, fq); S.done(cur); }
        if (!has_next) break;
        if (!Epi::HAS_MID || cur.kofs != 0)
#pragma unroll
        for (int a = 0; a < 2; ++a)
#pragma unroll
            for (int b = 0; b < 2; ++b)
#pragma unroll
                for (int m = 0; m < 4; ++m)
#pragma unroll
                    for (int n = 0; n < 2; ++n) acc[a][b][m][n] = (f32x4){0.f, 0.f, 0.f, 0.f};
        cur = nxt; cA = nA; cB = nB; ++ui;
        PG8_LANE_SETUP();
        if constexpr (ALIGN_EPI) { if (wr == 1) PG8_BAR; }
    }
    PG8_WAIT_V(0);
    if constexpr (!ALIGN_EPI) { if (wr == 0) PG8_BAR; }
    PG8_BAR;
    if constexpr (Epi::AFTER_DRAIN) { E.fused(acc, cur, wr, wc, fr, fq, lds, wid, lane_); S.done(cur); }
#undef PG8_LANE_SETUP
#undef PG8_SA
#undef PG8_SB
#undef PG8_STAGE
#undef PG8_LDA
#undef PG8_LDB
#undef PG8_MMA
#undef PG8_CAT
#undef PG8_WAIT_V
#undef PG8_WAIT_L
#undef PG8_BAR
#undef PG8_SCHED
}
}

#ifndef PG8_SP2
#define PG8_SP2 true
#endif
#ifndef PG8_ALIGN
#define PG8_ALIGN true
#endif
#include <hip/hip_bf16.h>
#include <cmath>
namespace attn_body {
using bf16=__hip_bfloat16;
using bf16x8=__attribute__((ext_vector_type(8)))short;
using s16x4=__attribute__((ext_vector_type(4)))short;
using f32x16=__attribute__((ext_vector_type(16)))float;
using u32x4=__attribute__((ext_vector_type(4)))unsigned;
constexpr int BATCH=16,NHEAD=16,SEQ=2048,D=64,DM=NHEAD*D,KVP=256,META_ROW0=32768,OP=2048;
constexpr int NW=8,QBLK=32,QB=QBLK*NW,KVBLK=64,NQB=SEQ/QB;
constexpr int ATTN_PITCH=DM, ATTN_UNIT_ROWS=QB;
__device__ __forceinline__ int crow(int r,int hi){return (r&3)+8*(r>>2)+4*hi;}
#define SBAR() __builtin_amdgcn_sched_barrier(0)
__device__ __forceinline__ void cmask(f32x16&p0,f32x16&p1,int jb,int qrel,int hi){
  const float NEG=-INFINITY; int kb=64*jb+4*hi;
  #pragma unroll
  for(int r=0;r<16;++r){int kv=kb+(r&3)+8*(r>>2); if(kv>qrel)p0[r]=NEG; if(kv+32>qrel)p1[r]=NEG;}
}

constexpr int NSLOT=3, SLOTB=8192;
constexpr int LDS_K=0, LDS_V=NSLOT*SLOTB, LDS_WS=2*NSLOT*SLOTB, LDS_OST=LDS_WS+NW*64*4, LDS_BYTES=LDS_OST+NW*4096;
constexpr float C2=0.125f*1.4426950408889634f;
__device__ __forceinline__ void glds16(const void*gsrc,unsigned lds_dst){unsigned keep;
  asm volatile("s_mov_b32 %0, m0\n\ts_mov_b32 m0, %2\n\ts_nop 0\n\tglobal_load_lds_dwordx4 %1, off\n\ts_mov_b32 m0, %0":"=&s"(keep):"v"(gsrc),"s"(lds_dst):"memory");}
__device__ __forceinline__ float max3f(float a,float b,float c){float r;asm("v_max3_f32 %0, %1, %2, %3":"=v"(r):"v"(a),"v"(b),"v"(c));return r;}
__device__ __forceinline__ float max2f(float a,float b){float r;asm("v_max_f32_e32 %0, %1, %2":"=v"(r):"v"(a),"v"(b));return r;}
__device__ __forceinline__ float fadd_s(float a,float b){float r;asm("v_add_f32_e32 %0, %1, %2":"=v"(r):"v"(a),"v"(b));return r;}
__device__ __forceinline__ float fsub_s(float a,float b){float r;asm("v_sub_f32_e32 %0, %1, %2":"=v"(r):"v"(a),"v"(b));return r;}
typedef float f32x2_t __attribute__((ext_vector_type(2))); typedef __bf16 bf16x2_t __attribute__((ext_vector_type(2)));
__device__ __forceinline__ unsigned cvtpk_s(float lo,float hi){f32x2_t v={lo,hi};bf16x2_t b=__builtin_convertvector(v,bf16x2_t);return __builtin_bit_cast(unsigned,b);}
#define WAIT_BAR(N) asm volatile("s_waitcnt vmcnt(" #N ") lgkmcnt(0)\n\ts_barrier":::"memory")

__device__ __forceinline__ void qkt(f32x16&p0,f32x16&p1,const char*Kslot,const bf16x8*qr,const f32x16&negm,int r32,int hi){
  const char*kb=Kslot+hi*1024+r32*16;
  #pragma unroll
  for(int d0=0;d0<4;++d0){
    const bf16x8 b0=*reinterpret_cast<const bf16x8*>(kb+d0*2048);
    const bf16x8 b1=*reinterpret_cast<const bf16x8*>(kb+d0*2048+512);
    if(d0==0){p0=__builtin_amdgcn_mfma_f32_32x32x16_bf16(b0,qr[0],negm,0,0,0);p1=__builtin_amdgcn_mfma_f32_32x32x16_bf16(b1,qr[0],negm,0,0,0);}
    else{p0=__builtin_amdgcn_mfma_f32_32x32x16_bf16(b0,qr[d0],p0,0,0,0);p1=__builtin_amdgcn_mfma_f32_32x32x16_bf16(b1,qr[d0],p1,0,0,0);}}
}
typedef __attribute__((address_space(3))) const char* lds_cptr;
typedef short v4i16_t __attribute__((ext_vector_type(4)));
__device__ __forceinline__ void kload8(bf16x8*kf,lds_cptr kp){
  kf[0]=*(const __attribute__((address_space(3))) bf16x8*)(kp);      kf[1]=*(const __attribute__((address_space(3))) bf16x8*)(kp+512);
  kf[2]=*(const __attribute__((address_space(3))) bf16x8*)(kp+2048); kf[3]=*(const __attribute__((address_space(3))) bf16x8*)(kp+2560);
  kf[4]=*(const __attribute__((address_space(3))) bf16x8*)(kp+4096); kf[5]=*(const __attribute__((address_space(3))) bf16x8*)(kp+4608);
  kf[6]=*(const __attribute__((address_space(3))) bf16x8*)(kp+6144); kf[7]=*(const __attribute__((address_space(3))) bf16x8*)(kp+6656);
}
__device__ __forceinline__ void kload2(bf16x8*kf,lds_cptr kp,int j){ kf[2*j]=*(const __attribute__((address_space(3))) bf16x8*)(kp+j*2048); kf[2*j+1]=*(const __attribute__((address_space(3))) bf16x8*)(kp+j*2048+512); }
__device__ __forceinline__ s16x4 vtr(lds_cptr p){ return __builtin_bit_cast(s16x4,__builtin_amdgcn_ds_read_tr16_b64_v4i16((__attribute__((address_space(3))) v4i16_t*)p)); }
__device__ __forceinline__ float rowmax(const f32x16&p0,const f32x16&p1){
  float a=max3f(p0[0],p0[1],p1[0]),b=max3f(p0[2],p0[3],p1[1]);a=max3f(a,p1[2],p1[3]);
  #pragma unroll
  for(int r=4;r<16;r+=4){a=max3f(a,p0[r],p0[r+1]);b=max3f(b,p0[r+2],p0[r+3]);a=max3f(a,p1[r],p1[r+1]);b=max3f(b,p1[r+2],p1[r+3]);}
  const float m=max2f(a,b);
  auto rr=__builtin_amdgcn_permlane32_swap(__float_as_uint(m),__float_as_uint(m),false,false);
  return max2f(__uint_as_float(rr[0]),__uint_as_float(rr[1]));
}
__device__ __forceinline__ void pv(f32x16*o,int vb,bf16x8 pa0,bf16x8 pa1,bf16x8 pa2,bf16x8 pa3){
  #pragma unroll
  for(int d0=0;d0<2;++d0){s16x4 lo[4],hi[4];
    #pragma unroll
    for(int ks=0;ks<4;++ks){
      asm volatile("ds_read_b64_tr_b16 %0,%1 offset:%c2":"=&v"(lo[ks]):"v"(vb),"i"(d0*4096+ks*1024):"memory");
      asm volatile("ds_read_b64_tr_b16 %0,%1 offset:%c2":"=&v"(hi[ks]):"v"(vb),"i"(d0*4096+ks*1024+512):"memory");}
    asm volatile("s_waitcnt lgkmcnt(0)":::"memory");SBAR();
    #define PK(k) (bf16x8){lo[k][0],lo[k][1],lo[k][2],lo[k][3],hi[k][0],hi[k][1],hi[k][2],hi[k][3]}
    o[d0]=__builtin_amdgcn_mfma_f32_32x32x16_bf16(pa0,PK(0),o[d0],0,0,0);
    o[d0]=__builtin_amdgcn_mfma_f32_32x32x16_bf16(pa1,PK(1),o[d0],0,0,0);
    o[d0]=__builtin_amdgcn_mfma_f32_32x32x16_bf16(pa2,PK(2),o[d0],0,0,0);
    o[d0]=__builtin_amdgcn_mfma_f32_32x32x16_bf16(pa3,PK(3),o[d0],0,0,0);
    #undef PK
  }
}

#ifndef ATTN_STORE16
#define ATTN_STORE16(p,v) __builtin_nontemporal_store((v),(u32x4*)(p))
#endif
template<int THRL> __device__ __forceinline__ void attn_unit(int b,int h,int qb,const bf16*Q,const bf16*__restrict__ K,const bf16*__restrict__ V,bf16*O,const bf16*__restrict__ SAZ,char*shm,int wave_id){
  int lane_=(int)__builtin_amdgcn_mbcnt_hi(~0u,__builtin_amdgcn_mbcnt_lo(~0u,0u)); asm volatile("":"+v"(lane_)); const int lane=lane_,r32=lane&31,hi=lane>>5; const int wid=wave_id;
  const long rowbase=(long)b*SEQ; const int q0=qb*QB;
  const bf16*Qw=Q+(rowbase+q0+wid*QBLK)*DM+h*D;
  const int kvh=h>>2; const bf16*Kh=K+rowbase*KVP+kvh*D,*Vh=V+rowbase*KVP+kvh*D; const long metaoff=((long)META_ROW0-rowbase)*KVP;
  const unsigned lds0=(unsigned)(uintptr_t)shm;
  float*wsf=(float*)(shm+LDS_WS)+wid*64;
  const bf16*ksrc=Kh+(long)lane*KVP+wid*8;
  const bf16*vsrc=Vh+(long)(16*(wid&3)+(lane>>2))*KVP+(wid>>2)*32+(lane&3)*8;
  const unsigned kdst=lds0+LDS_K+wid*1024, vdst=lds0+LDS_V+wid*1024;
  #define TOFF(t) (((t)==0)?metaoff:(long)((t)-1)*KVBLK*KVP)
  #define DMA_K(t,slot) glds16(ksrc+TOFF(t),(unsigned)__builtin_amdgcn_readfirstlane(kdst+(slot)))
  #define DMA_V(t,slot) glds16(vsrc+TOFF(t),(unsigned)__builtin_amdgcn_readfirstlane(vdst+(slot)))
  const int vb0=(int)(lds0+LDS_V)+((lane>>4)&1)*32+(lane&3)*8+(4*hi+((lane&15)>>2))*64;
  const char*Kbase=shm+LDS_K; bf16x8 kf[8];
  const lds_cptr shm3=(lds_cptr)shm; const lds_cptr kp0=shm3+LDS_K+hi*1024+r32*16; const lds_cptr vp0=shm3+LDS_V+((lane>>4)&1)*32+(lane&3)*8+(4*hi+((lane&15)>>2))*64;
  constexpr int NT=33;
  DMA_K(0,0);DMA_V(0,0);DMA_K(1,SLOTB);
  bf16x8 qr[4];
  #pragma unroll
  for(int d0=0;d0<4;++d0)qr[d0]=*reinterpret_cast<const bf16x8*>(&Qw[(long)r32*DM+d0*16+hi*8]);
  float mhat=0.f,l_reg=0.f;f32x16 o[2];o[0]=f32x16{};o[1]=f32x16{};f32x16 negm=f32x16{};asm volatile("":"+v"(negm));
  const int qrel=wid*QBLK+r32;
  #define CMASK(P0,P1,t) do{}while(0)
  bool resc=false;
  #define START(P0,P1) do{ const float rm=rowmax(P0,P1); resc=false; \
    { const float dl=rm; mhat=fadd_s(mhat,dl); \
      _Pragma("unroll") for(int r=0;r<16;++r){P0[r]=fsub_s(P0[r],dl);P1[r]=fsub_s(P1[r],dl);} \
      _Pragma("unroll") for(int r=0;r<16;++r)negm[r]=-mhat; asm volatile("":"+v"(negm)); } \
    _Pragma("unroll") for(int r=0;r<16;++r)P0[r]=__builtin_amdgcn_exp2f(P0[r]); }while(0)
  #define RESC() do{ if(resc){ asm volatile("s_waitcnt lgkmcnt(0)":::"memory"); \
      _Pragma("unroll") for(int d_=0;d_<2;++d_) _Pragma("unroll") for(int r=0;r<16;++r)o[d_][r]*=wsf[crow(r,hi)]; } }while(0)
  f32x16 pA0,pA1,pB0,pB1;
  int sl_prev=0,sl_cur=0,sl_next=SLOTB;
  #define ROT() do{sl_prev=sl_cur;sl_cur=sl_next;sl_next=(sl_next==(NSLOT-1)*SLOTB)?0:sl_next+SLOTB;}while(0)
  DMA_K(2,2*SLOTB);
  WAIT_BAR(3);
  qkt(pA0,pA1,Kbase,qr,negm,r32,hi);asm volatile("s_nop 15\n\ts_nop 7":"+v"(pA0),"+v"(pA1));
  { const float NEG=-INFINITY; _Pragma("unroll") for(int r=8;r<16;++r)pA0[r]=NEG; _Pragma("unroll") for(int r=0;r<16;++r)pA1[r]=NEG; }
  START(pA0,pA1);
  _Pragma("unroll") for(int r=0;r<16;++r)pA1[r]=__builtin_amdgcn_exp2f(pA1[r]);
  WAIT_BAR(0);
  DMA_K(3,0);DMA_V(1,SLOTB);
  ROT();
  kload8(kf,kp0+sl_cur);
  WAIT_BAR(2);
  s16x4 vlo[8],vhi[8]; u32x4 pw0,pw1,pw2,pw3;
  #define PKW(P,B) cvtpk_s(P[B],P[B+1])
  #define PAF(k) __builtin_bit_cast(bf16x8,pw##k)
  #define VFR(i) (bf16x8){vlo[i][0],vlo[i][1],vlo[i][2],vlo[i][3],vhi[i][0],vhi[i][1],vhi[i][2],vhi[i][3]}
  #define PIN(x) asm volatile("":"+v"(x))
  #define MX3(a,b,c) __builtin_fmaxf(__builtin_fmaxf((a),(b)),(c))
  #define GAPA(MF,A0,A1,A2,A3,W0,W1,PW) do{ MF; sacc+=A0; sacc+=A1; sacc+=A2; sacc+=A3; PIN(sacc); W0; W1; PIN(PW); SBAR(); }while(0)
  #define EX(v) __builtin_amdgcn_exp2f(v)
  #define GAPB(MF,X,B) do{ MF; X[B]=EX(X[B]); X[B+1]=EX(X[B+1]); X[B+2]=EX(X[B+2]); X[B+3]=EX(X[B+3]); PIN(X); SBAR(); }while(0)
  #define VRD(i) do{ vlo[i]=vtr(vp_+(((i)>>2)*4096+((i)&3)*1024)); vhi[i]=vtr(vp_+(((i)>>2)*4096+((i)&3)*1024+512)); }while(0)
  #define KRD(G,j) do{ if(G){ kload2(kf,kp0+sl_next,j); SBAR(); } }while(0)
  #define STEP(C0,C1,P0,P1,t,GK,GV,GL) do{ SBAR(); \
    const lds_cptr vp_=vp0+sl_prev; \
    VRD(0); SBAR(); float sacc=(P0[0]+P0[1]); \
    GAPA(C0=__builtin_amdgcn_mfma_f32_32x32x16_bf16(kf[0],qr[0],negm,0,0,0), P0[2],P0[3],P0[4],P0[5],     pw0[0]=PKW(P0,0), pw0[1]=PKW(P0,2), pw0); \
    VRD(4); SBAR(); GAPA(C1=__builtin_amdgcn_mfma_f32_32x32x16_bf16(kf[1],qr[0],negm,0,0,0), P0[6],P0[7],P0[8],P0[9],     pw0[2]=PKW(P0,4), pw0[3]=PKW(P0,6), pw0); \
    VRD(1); SBAR(); GAPA(C0=__builtin_amdgcn_mfma_f32_32x32x16_bf16(kf[2],qr[1],C0,0,0,0),   P0[10],P0[11],P0[12],P0[13], pw1[0]=PKW(P0,8), pw1[1]=PKW(P0,10), pw1); \
    VRD(5); SBAR(); GAPA(C1=__builtin_amdgcn_mfma_f32_32x32x16_bf16(kf[3],qr[1],C1,0,0,0),   P0[14],P0[15],P1[0],P1[1],   pw1[2]=PKW(P0,12),pw1[3]=PKW(P0,14), pw1); \
    VRD(2); SBAR(); GAPA(C0=__builtin_amdgcn_mfma_f32_32x32x16_bf16(kf[4],qr[2],C0,0,0,0),   P1[2],P1[3],P1[4],P1[5],     pw2[0]=PKW(P1,0), pw2[1]=PKW(P1,2), pw2); \
    VRD(6); SBAR(); GAPA(C1=__builtin_amdgcn_mfma_f32_32x32x16_bf16(kf[5],qr[2],C1,0,0,0),   P1[6],P1[7],P1[8],P1[9],     pw2[2]=PKW(P1,4), pw2[3]=PKW(P1,6), pw2); \
    VRD(3); SBAR(); GAPA(C0=__builtin_amdgcn_mfma_f32_32x32x16_bf16(kf[6],qr[3],C0,0,0,0),   P1[10],P1[11],P1[12],P1[13], pw3[0]=PKW(P1,8), pw3[1]=PKW(P1,10), pw3); \
    VRD(7); SBAR(); GAPA(C1=__builtin_amdgcn_mfma_f32_32x32x16_bf16(kf[7],qr[3],C1,0,0,0),   P1[14],P1[15],0.f,0.f,       pw3[2]=PKW(P1,12),pw3[3]=PKW(P1,14), pw3); \
    l_reg+=sacc; \
    if(GK){DMA_K((t)+3,sl_cur);} if(GV){DMA_V((t)+1,sl_next);} \
    CMASK(C0,C1,t); \
    { float a=MX3(C0[0],C0[1],C1[0]),b=MX3(C0[2],C0[3],C1[1]); a=MX3(a,C1[2],C1[3]); \
      _Pragma("unroll") for(int r=4;r<16;r+=4){a=MX3(a,C0[r],C0[r+1]);b=MX3(b,C0[r+2],C0[r+3]);a=MX3(a,C1[r],C1[r+1]);b=MX3(b,C1[r+2],C1[r+3]);} \
      float rm=__builtin_fmaxf(a,b); { auto rr=__builtin_amdgcn_permlane32_swap(__float_as_uint(rm),__float_as_uint(rm),false,false); rm=__builtin_fmaxf(__uint_as_float(rr[0]),__uint_as_float(rr[1])); } \
      resc=false; \
      if(__builtin_expect(__any(rm>(float)THRL),0)){ const float dl=__builtin_fmaxf(rm,0.f); mhat+=dl; \
        _Pragma("unroll") for(int r=0;r<16;++r){C0[r]-=dl;C1[r]-=dl;} \
        _Pragma("unroll") for(int r=0;r<16;++r)negm[r]=-mhat; asm volatile("":"+v"(negm)); \
        const float f=__builtin_amdgcn_exp2f(-dl); l_reg*=f; if(hi==0)wsf[r32]=f; resc=true; } } \
    SBAR(); \
    GAPB(o[0]=__builtin_amdgcn_mfma_f32_32x32x16_bf16(PAF(0),VFR(0),o[0],0,0,0), C0,0); \
    GAPB(o[1]=__builtin_amdgcn_mfma_f32_32x32x16_bf16(PAF(0),VFR(4),o[1],0,0,0), C0,4); \
    KRD(GL,0); GAPB(o[0]=__builtin_amdgcn_mfma_f32_32x32x16_bf16(PAF(1),VFR(1),o[0],0,0,0), C0,8); \
    KRD(GL,1); GAPB(o[1]=__builtin_amdgcn_mfma_f32_32x32x16_bf16(PAF(1),VFR(5),o[1],0,0,0), C0,12); \
    KRD(GL,2); GAPB(o[0]=__builtin_amdgcn_mfma_f32_32x32x16_bf16(PAF(2),VFR(2),o[0],0,0,0), C1,0); \
    KRD(GL,3); GAPB(o[1]=__builtin_amdgcn_mfma_f32_32x32x16_bf16(PAF(2),VFR(6),o[1],0,0,0), C1,4); \
    GAPB(o[0]=__builtin_amdgcn_mfma_f32_32x32x16_bf16(PAF(3),VFR(3),o[0],0,0,0), C1,8); \
    GAPB(o[1]=__builtin_amdgcn_mfma_f32_32x32x16_bf16(PAF(3),VFR(7),o[1],0,0,0), C1,12); \
    }while(0)
  int t=1;


  for(;t+5<NT;t+=2){
    STEP(pB0,pB1,pA0,pA1,t,true,true,true);     WAIT_BAR(2); RESC(); ROT();
    STEP(pA0,pA1,pB0,pB1,t+1,true,true,true);   WAIT_BAR(2); RESC(); ROT();
  }


  #define ENDW(tt) do{ if((tt)+3<NT){WAIT_BAR(2);} else if((tt)+2<NT){WAIT_BAR(1);} else {WAIT_BAR(0);} }while(0)
  for(;t+2<NT;t+=2){
    STEP(pB0,pB1,pA0,pA1,t,(t+3<NT),(t+1<NT),(t+1<NT));       ENDW(t);   RESC(); ROT();
    STEP(pA0,pA1,pB0,pB1,t+1,(t+4<NT),(t+2<NT),(t+2<NT));     ENDW(t+1); RESC(); ROT();
  }
  STEP(pB0,pB1,pA0,pA1,NT-2,false,true,true); ENDW(NT-2); RESC(); ROT();
  STEP(pA0,pA1,pB0,pB1,NT-1,false,false,false); RESC();
  { float sacc=pA0[0]+pA0[1]; _Pragma("unroll") for(int r=2;r<16;++r)sacc+=pA0[r]; _Pragma("unroll") for(int r=0;r<16;++r)sacc+=pA1[r]; l_reg+=sacc;
    pw0=(u32x4){PKW(pA0,0),PKW(pA0,2),PKW(pA0,4),PKW(pA0,6)};pw1=(u32x4){PKW(pA0,8),PKW(pA0,10),PKW(pA0,12),PKW(pA0,14)};pw2=(u32x4){PKW(pA1,0),PKW(pA1,2),PKW(pA1,4),PKW(pA1,6)};pw3=(u32x4){PKW(pA1,8),PKW(pA1,10),PKW(pA1,12),PKW(pA1,14)};
    SBAR(); pv(o,vb0+sl_cur,PAF(0),PAF(1),PAF(2),PAF(3)); }
  #undef PKW
  #undef PAF
  #undef VFR
  #undef PIN
  #undef MX3
  #undef GAPA
  #undef GAPB
  #undef EX
  #undef VRD
  #undef KRD
  #undef STEP
  #undef ENDW
  {auto rr=__builtin_amdgcn_permlane32_swap(__float_as_uint(l_reg),__float_as_uint(l_reg),false,false);l_reg=__uint_as_float(rr[0])+__uint_as_float(rr[1]);}
  if(hi==0)wsf[32+r32]=l_reg;asm volatile("s_waitcnt lgkmcnt(0)":::"memory");
  float rli[16];
  #pragma unroll
  for(int r=0;r<16;++r)rli[r]=__builtin_amdgcn_rcpf(wsf[32+crow(r,hi)]);
  bf16*Ow=O+(rowbase+q0+wid*QBLK)*OP+h*D;
  { bf16*stg=(bf16*)(shm+LDS_OST)+wid*2048;
    #pragma unroll
    for(int r=0;r<16;++r){const int orow=crow(r,hi);
      #pragma unroll
      for(int d0=0;d0<2;++d0)stg[orow*64+d0*32+r32]=__float2bfloat16(o[d0][r]*rli[r]);}
    asm volatile("s_waitcnt lgkmcnt(0)":::"memory");
    const bf16*Zw=SAZ+(rowbase+q0+wid*QBLK)*DM+h*D;
    #pragma unroll
    for(int i=0;i<4;++i){const int row=i*8+(lane>>3),ch=lane&7; const u32x4 v=*(const u32x4*)(stg+row*64+ch*8); const u32x4 z=*(const u32x4*)(Zw+(long)row*DM+ch*8); u32x4 w;
      #pragma unroll
      for(int e=0;e<4;++e){ const float a0=__uint_as_float(v[e]<<16)*__uint_as_float(z[e]<<16), a1=__uint_as_float(v[e]&0xffff0000u)*__uint_as_float(z[e]&0xffff0000u); w[e]=cvtpk_s(a0,a1);}
      ATTN_STORE16(Ow+(long)row*OP+ch*8,w);} }
  asm volatile("s_waitcnt lgkmcnt(0)\n\ts_barrier":::"memory");
  #undef DMA_K
  #undef TOFF
  #undef DMA_V
  #undef CMASK
  #undef START
  #undef RESC
  #undef ROT
}
constexpr int ATTN_LDS_BYTES=LDS_BYTES;
struct AttnTensors { const bf16* Q; const bf16* K; const bf16* V; bf16* O; const bf16* SAZ; };
template<int THRL=8> __device__ __forceinline__ void attn_phase(char*lds,const AttnTensors&T,int vcu,int G,int wave_id,int u0,int u1){
  if(G==256){
    const int x=vcu>>5,v=vcu&31,s=v&7,hl=s>>1,qh=s&1;
    for(int u=u0;u<u1;++u){ const int r=u>>2,j=u&3; const int grp=x*8+r*4+(v>>3), b=grp>>2, kvh=grp&3, h=kvh*4+hl;
      attn_unit<THRL>(b,h,4*qh+j,T.Q,T.K,T.V,T.O,T.SAZ,lds,wave_id); }
  } else if(u0==0) {
    const int NU=BATCH*NHEAD*NQB, upc=(NU+G-1)/G;
    for(int i=0;i<upc;++i){ const int id=vcu*upc+i; if(id>=NU)break; const int bh=id/NQB, qb=id%NQB; attn_unit<THRL>(bh/NHEAD,bh%NHEAD,qb,T.Q,T.K,T.V,T.O,T.SAZ,lds,wave_id); }
  }
}
#undef SBAR
#undef WAIT_BAR
}
#include <hip/hip_cooperative_groups.h>
namespace cg = cooperative_groups;
constexpr int NWAVES = 8;
constexpr int MR = 32768, MP = 33024, DMODEL = 1024, NIN = 7680, SEQL = 2048, NBATCH = 16, NMETA = 16;
constexpr size_t MiB = 1u << 20;
constexpr size_t BIG = (size_t)MP * DMODEL * 2, SMALL = (size_t)MP * 256 * 2;
constexpr size_t WS_TAB = 0;
constexpr size_t WS_ROPE = 1 * MiB;
constexpr size_t WS_WIN = 2 * MiB, WS_WC = 17 * MiB, WS_WA = 19 * MiB, WS_WO = 21 * MiB;
constexpr size_t WS_XN = 24 * MiB;
constexpr size_t WS_U = WS_XN + BIG;
constexpr size_t WS_SZ = WS_U + BIG;
constexpr size_t WS_Q = WS_SZ + BIG;
constexpr size_t WS_SAZ = WS_Q + BIG, WS_GCS = WS_SAZ + BIG, WS_GAS = WS_GCS + BIG, WS_K = WS_GAS + BIG, WS_V = WS_K + SMALL, WS_END = WS_V + SMALL;
static_assert(WS_END <= 512 * MiB, "d_ws map");
constexpr int RING_BYTES = 131072, LDS_BYTES = 147456;
constexpr size_t OUT_XN8 = 0, OUT_W8 = 32 * MiB;

#define LAS __attribute__((address_space(3)))
typedef unsigned short bf16;
typedef unsigned v4u __attribute__((ext_vector_type(4)));
typedef unsigned v2u __attribute__((ext_vector_type(2)));
typedef float f32x4 __attribute__((ext_vector_type(4)));
typedef float f32x2 __attribute__((ext_vector_type(2)));
#define LDS_WAIT() asm volatile("s_waitcnt lgkmcnt(0)" ::: "memory")
__device__ __forceinline__ unsigned pk2(float lo, float hi) { return pg8::cvt_pk_bf16(lo, hi); }
__device__ __forceinline__ float shx(float v, int mask, int lane) { return __int_as_float(__builtin_amdgcn_ds_bpermute((lane ^ mask) << 2, __float_as_int(v))); }
__device__ __forceinline__ float wave_sum(float v, int lane) {
#pragma unroll
    for (int o = 1; o < 64; o <<= 1) v += shx(v, o, lane);
    return v;
}
__device__ __forceinline__ int in_src_col(int np) {
    const int pn = np >> 8, p = np & 255, bj = p >> 7, wc = (p >> 5) & 3, i = p & 31;
    const int d = 32 * bj + 16 * ((i >> 2) & 1) + 4 * (i >> 3) + (i & 3);
    if (pn < 8) return (bj ? 1024 : 0) + pn * 128 + (p & 127);
    if (pn < 12) return 2048 + (pn - 8) * 256 + p;
    if (pn < 16) return 3072 + ((pn - 12) * 4 + wc) * 64 + d;
    if (pn == 16) return 4096 + wc * 64 + d;
    if (pn == 17) return 4352 + p;
    if (pn < 22) return 4608 + (pn - 18) * 256 + p;
    return 5632 + (pn - 22) * 256 + p;
}
template <bool PERMUTE> __device__ __forceinline__ void p0_transpose_item(const float* W, int K, int N, bf16* WT, int ldk, unsigned char* W8, LAS float* scr, int item, int lane) {
    const int nblk = N / 32, kb = item / nblk, nb = item % nblk, k0 = 64 * kb, n0 = 32 * nb;
    const int sc = PERMUTE ? in_src_col(n0 + (lane & 31)) : n0 + (lane & 31);
    float wv[32];
#pragma unroll
    for (int i = 0; i < 32; ++i) wv[i] = W[(size_t)(k0 + 2 * i + (lane >> 5)) * N + sc];
#pragma unroll
    for (int i = 0; i < 32; ++i) scr[(2 * i + (lane >> 5)) * 33 + (lane & 31)] = wv[i];
    LDS_WAIT(); asm volatile("" ::: "memory");
    const int c = lane & 7;
#pragma unroll
    for (int j = 0; j < 4; ++j) { const int n = (lane >> 3) + 8 * j; const LAS float* s = scr + (8 * c) * 33 + n;
        v4u o; o.x = pk2(s[0 * 33], s[1 * 33]); o.y = pk2(s[2 * 33], s[3 * 33]); o.z = pk2(s[4 * 33], s[5 * 33]); o.w = pk2(s[6 * 33], s[7 * 33]);
        bool wbf = true; if (PERMUTE) { const int pn = n0 >> 8; wbf = pn < 12 || pn == 16 || pn == 17 || (pn >= 22 && pn < 26); }
        if (wbf) *(v4u*)(WT + (size_t)(n0 + n) * ldk + k0 + 8 * c) = o;
        if (PERMUTE) { const int pn = n0 >> 8; if ((pn >= 12 && pn < 22) || pn >= 26) {
            const int pb = pn < 22 ? pn - 12 : pn - 16; int w0 = 0, w1 = 0;
            w0 = __builtin_amdgcn_cvt_pk_fp8_f32(64.f * s[0 * 33], 64.f * s[1 * 33], w0, false); w0 = __builtin_amdgcn_cvt_pk_fp8_f32(64.f * s[2 * 33], 64.f * s[3 * 33], w0, true);
            w1 = __builtin_amdgcn_cvt_pk_fp8_f32(64.f * s[4 * 33], 64.f * s[5 * 33], w1, false); w1 = __builtin_amdgcn_cvt_pk_fp8_f32(64.f * s[6 * 33], 64.f * s[7 * 33], w1, true);
            v2u o8; o8.x = (unsigned)w0; o8.y = (unsigned)w1; *(v2u*)(W8 + (size_t)(256 * pb + ((n0 + n) & 255)) * 1024 + k0 + 8 * c) = o8; } } }
    LDS_WAIT(); asm volatile("" ::: "memory");
}
__device__ __forceinline__ void rms_row_to_bf16(const float* xrow, const float* g, bf16* orow, unsigned char* orow8, int lane) {
    const f32x4* xr = (const f32x4*)xrow + lane; const f32x4* gr = (const f32x4*)g + lane;
    f32x4 v[4]; float s = 0.f;
#pragma unroll
    for (int j = 0; j < 4; ++j) { v[j] = xr[64 * j]; s += (v[j].x * v[j].x + v[j].y * v[j].y) + (v[j].z * v[j].z + v[j].w * v[j].w); }
    const float rstd = 1.f / sqrtf(wave_sum(s, lane) * (1.f / 1024.f) + 1e-6f);
    v2u* o8 = (v2u*)orow + lane;
#pragma unroll
    for (int j = 0; j < 4; ++j) { const f32x4 y = v[j] * rstd * gr[64 * j]; v2u w; w.x = pk2(y.x, y.y); w.y = pk2(y.z, y.w); o8[64 * j] = w;
        if (orow8) { int q = 0; q = __builtin_amdgcn_cvt_pk_fp8_f32(y.x, y.y, q, false); q = __builtin_amdgcn_cvt_pk_fp8_f32(y.z, y.w, q, true); ((unsigned*)orow8)[lane + 64 * j] = (unsigned)q; } }
}
#define RLX_AGENT __ATOMIC_RELAXED, __HIP_MEMORY_SCOPE_AGENT
#define XB_TMO      128
#define XB_XCNT(j)  (256  + 64 * (j))
#define XB_XSUB(j)  (1280 + 64 * (j))
#define XB_XGEN(j)  (2304 + 64 * (j))
#define XB_TOP      3328
#define XB_TOPGEN   3392
#define XCD_BAR_WORDS 3456
#define XB_SPIN_CAP (1u << 18)

__device__ __forceinline__ unsigned xb_ld(unsigned* p)              { return __hip_atomic_load(p, __ATOMIC_RELAXED, __HIP_MEMORY_SCOPE_AGENT); }
__device__ __forceinline__ unsigned xb_add(unsigned* p, unsigned v) { return __hip_atomic_fetch_add(p, v, __ATOMIC_RELAXED, __HIP_MEMORY_SCOPE_AGENT); }
__device__ __forceinline__ unsigned xb_xcc_id() { return (unsigned)__builtin_amdgcn_s_getreg((3 << 11) | 20) & 0xFu; }
#define XB_SPIN(cond, bar) do { unsigned _sp = 0; while (cond) { __builtin_amdgcn_s_sleep(1); \
    if ((++_sp & 255u) == 0u) { if (xb_ld(&(bar)[XB_TMO])) break; if (_sp > XB_SPIN_CAP) { atomicAdd(&(bar)[XB_TMO], 1u); break; } } } } while (0)

struct XcdBarrier {
    unsigned* bar; unsigned x;
    volatile LAS unsigned* st;
};

__device__ __forceinline__ XcdBarrier xcd_barrier_post(unsigned* bar, volatile LAS unsigned* st, bool t0) {
    XcdBarrier b; b.bar = bar; b.x = xb_xcc_id(); b.st = st;
    if (t0) (void)xb_add(&bar[XB_XCNT(b.x)], 1u);
    return b;
}
__device__ __forceinline__ void xcd_barrier_complete(unsigned* bar, unsigned x, unsigned& nloc, unsigned& nx) {
    const unsigned G = gridDim.x * gridDim.y * gridDim.z;
    unsigned sum, cnt, mine, sp = 0u;
    for (;;) {
        sum = 0u; cnt = 0u; mine = 0u;
#pragma unroll
        for (unsigned j = 0; j < 16; ++j) { const unsigned c = xb_ld(&bar[XB_XCNT(j)]); sum += c; cnt += (c > 0u) ? 1u : 0u; mine = (j == x) ? c : mine; }
        if (sum == G) break;
        __builtin_amdgcn_s_sleep(1);
        if ((++sp & 255u) == 0u) { if (xb_ld(&bar[XB_TMO])) break; if (sp > XB_SPIN_CAP) { atomicAdd(&bar[XB_TMO], 1u); break; } }
    }
    nloc = mine > 0u ? mine : 1u; nx = cnt > 0u ? cnt : 1u;
}

__device__ __forceinline__ void xcd_barrier(const XcdBarrier& b, bool t0) {
    asm volatile("s_waitcnt vmcnt(0)" ::: "memory");
    __syncthreads();
    if (t0) {
        unsigned* bar = b.bar;
        __builtin_amdgcn_s_waitcnt(0);
        unsigned nloc = b.st[0], nx = b.st[1];
        if (nloc == 0u) { xcd_barrier_complete(bar, b.x, nloc, nx); b.st[0] = nloc; b.st[1] = nx; }
        const unsigned old = xb_add(&bar[XB_XSUB(b.x)], 1u);
        const unsigned gen = old / nloc;
        if (old + 1u == (gen + 1u) * nloc) {
            __builtin_amdgcn_fence(__ATOMIC_RELEASE, "agent");
            asm volatile("s_waitcnt vmcnt(0)" ::: "memory");
            const unsigned og = xb_add(&bar[XB_TOP], 1u);
            const unsigned tg = og / nx;
            if (og + 1u == (tg + 1u) * nx) xb_add(&bar[XB_TOPGEN], 1u);
            else XB_SPIN(xb_ld(&bar[XB_TOPGEN]) == tg, bar);
            __builtin_amdgcn_fence(__ATOMIC_ACQUIRE, "agent");
            xb_add(&bar[XB_XGEN(b.x)], 1u);
            asm volatile("s_waitcnt vmcnt(0)" ::: "memory");
        } else {
            XB_SPIN(xb_ld(&bar[XB_XGEN(b.x)]) == gen, bar);
            __builtin_amdgcn_fence(__ATOMIC_ACQUIRE, "agent");
            asm volatile("s_waitcnt vmcnt(0)" ::: "memory");
        }
    }
    __syncthreads();
}

constexpr size_t WS_CTL = 0, CTL_ZERO_BYTES = 65536; constexpr int CW_BAR = 1024;
constexpr int LDSCTL_OFF = RING_BYTES, MISC_OFF = LDSCTL_OFF + 320;
#define LANE_ID() ({ unsigned zl_ = 0u; asm volatile("" : "+s"(zl_)); (int)__builtin_amdgcn_mbcnt_hi(~0u, __builtin_amdgcn_mbcnt_lo(~0u, zl_)); })
struct Args { const float *x, *meta, *norm_g, *w_in, *conv_w, *conv_b, *cn_g, *cn_b, *w_conv_out, *q_g, *k_g, *w_attn_out, *w_out; float* out; unsigned char* ws; int ph_lo, ph_hi; };

__device__ __forceinline__ void p0_prologue(const Args& a, LAS unsigned char* lds, int vcu, int G, int tid, int lane, int wave) {
    unsigned char* ws = a.ws;
    LAS float* scr = (LAS float*)(lds + wave * 16384);
    const int gw = vcu * NWAVES + wave, NGW = G * NWAVES;
    constexpr int I_IN = (DMODEL / 64) * (NIN / 32), I_SQ = (DMODEL / 64) * (DMODEL / 32), NITEMS = I_IN + 3 * I_SQ;
    for (int it = gw; it < NITEMS; it += NGW) {
        int r = it;
        if (r < I_IN) { p0_transpose_item<true>(a.w_in, DMODEL, NIN, (bf16*)(ws + WS_WIN), DMODEL, (unsigned char*)a.out + OUT_W8, scr, r, lane); continue; } r -= I_IN;
        if (r < I_SQ) { p0_transpose_item<false>(a.w_conv_out, DMODEL, DMODEL, (bf16*)(ws + WS_WC), 2 * DMODEL, nullptr, scr, r, lane); continue; } r -= I_SQ;
        if (r < I_SQ) { p0_transpose_item<false>(a.w_attn_out, DMODEL, DMODEL, (bf16*)(ws + WS_WC) + DMODEL, 2 * DMODEL, nullptr, scr, r, lane); continue; } r -= I_SQ;
        p0_transpose_item<false>(a.w_out, DMODEL, DMODEL, (bf16*)(ws + WS_WO), DMODEL, nullptr, scr, r, lane);
    }
    bf16* XN = (bf16*)(ws + WS_XN); unsigned char* XN8 = (unsigned char*)a.out + OUT_XN8;
    int m = gw;
    for (; m + NGW < MR; m += 2 * NGW) {
        const int m1 = m + NGW;
        const f32x4* x0 = (const f32x4*)(a.x + (size_t)m * DMODEL) + lane; const f32x4* x1 = (const f32x4*)(a.x + (size_t)m1 * DMODEL) + lane; const f32x4* gr = (const f32x4*)a.norm_g + lane;
        f32x4 v0[4], v1[4]; float s0 = 0.f, s1 = 0.f;
#pragma unroll
        for (int j = 0; j < 4; ++j) { v0[j] = x0[64 * j]; v1[j] = x1[64 * j]; }
#pragma unroll
        for (int j = 0; j < 4; ++j) { s0 += (v0[j].x * v0[j].x + v0[j].y * v0[j].y) + (v0[j].z * v0[j].z + v0[j].w * v0[j].w); s1 += (v1[j].x * v1[j].x + v1[j].y * v1[j].y) + (v1[j].z * v1[j].z + v1[j].w * v1[j].w); }
#pragma unroll
        for (int o = 1; o < 64; o <<= 1) { s0 += shx(s0, o, lane); s1 += shx(s1, o, lane); }
        const float r0 = 1.f / sqrtf(s0 * (1.f / 1024.f) + 1e-6f), r1 = 1.f / sqrtf(s1 * (1.f / 1024.f) + 1e-6f);
        v2u* o0 = (v2u*)(XN + (size_t)m * DMODEL) + lane; v2u* o1 = (v2u*)(XN + (size_t)m1 * DMODEL) + lane;
#pragma unroll
        for (int j = 0; j < 4; ++j) { const f32x4 gg = gr[64 * j]; const f32x4 y0 = v0[j] * r0 * gg, y1 = v1[j] * r1 * gg; v2u w0, w1; w0.x = pk2(y0.x, y0.y); w0.y = pk2(y0.z, y0.w); w1.x = pk2(y1.x, y1.y); w1.y = pk2(y1.z, y1.w); o0[64 * j] = w0; o1[64 * j] = w1;
            int q0 = 0, q1 = 0; q0 = __builtin_amdgcn_cvt_pk_fp8_f32(y0.x, y0.y, q0, false); q0 = __builtin_amdgcn_cvt_pk_fp8_f32(y0.z, y0.w, q0, true); q1 = __builtin_amdgcn_cvt_pk_fp8_f32(y1.x, y1.y, q1, false); q1 = __builtin_amdgcn_cvt_pk_fp8_f32(y1.z, y1.w, q1, true);
            ((unsigned*)(XN8 + (size_t)m * DMODEL))[lane + 64 * j] = (unsigned)q0; ((unsigned*)(XN8 + (size_t)m1 * DMODEL))[lane + 64 * j] = (unsigned)q1; }
    }
    for (; m < MR + 64; m += NGW) {
        if (m < MR) rms_row_to_bf16(a.x + (size_t)m * DMODEL, a.norm_g, XN + (size_t)m * DMODEL, XN8 + (size_t)m * DMODEL, lane);
        else if (m < MR + NMETA) rms_row_to_bf16(a.meta + (size_t)(m - MR) * DMODEL, a.norm_g, XN + (size_t)m * DMODEL, nullptr, lane);
        else { const v2u z = {0u, 0u};
            ((v2u*)((bf16*)(ws + WS_K) + (size_t)m * 256))[lane] = z; ((v2u*)((bf16*)(ws + WS_V) + (size_t)m * 256))[lane] = z; }
    }
    if (blockIdx.x == 0) {
        float* rope = (float*)(ws + WS_ROPE);
        for (int idx = tid; idx < 1024; idx += NWAVES * 64) { const int pos = idx >> 4, f = idx & 15;
            const float inv = __builtin_amdgcn_exp2f(-(float)f * (13.287712379549449f / 16.0f)); const float ang = (float)pos * inv;
            rope[idx] = __cosf(ang); rope[1024 + idx] = __sinf(ang); }
    }
}

__device__ __forceinline__ void conv_phase(unsigned char* ws, const Args& a, LAS unsigned char* lds, int vcu, int G, int tid, int lane, int wave) {
    const bf16* U = (const bf16*)(ws + WS_U); const bf16* SZ = (const bf16*)(ws + WS_SZ); bf16* C = (bf16*)a.out;
    const float* conv_w = a.conv_w; const float* conv_b = a.conv_b; const float* cn_g = a.cn_g; const float* cn_b = a.cn_b;
    const int NU = NBATCH * (SEQL / 32), upc = (NU + G - 1) / G, ch = 2 * tid;
    LAS float* tile = (LAS float*)lds;
    f32x2 w[31];
#pragma unroll
    for (int j = 0; j < 31; ++j) w[j] = *(const f32x2*)(conv_w + j * 1024 + ch);
    const f32x2 bias = *(const f32x2*)(conv_b + ch);
    for (int i = 0; i < upc; ++i) {
        const int id = vcu * upc + i; if (id >= NU) break;
        const int b = id >> 6, t0 = (id & 63) * 32;
        f32x2 acc[32];
#pragma unroll
        for (int o = 0; o < 32; ++o) acc[o] = bias;
        unsigned raw[3][8];
#define CONV_LOAD(g, dst, tie) do { int tb_ = t0 - 15 + 8 * (g); asm volatile("" : "+s"(tb_), "+v"(tie)); \
            _Pragma("unroll") for (int r = 0; r < 8; ++r) if (8 * (g) + r < 62) { const int tt = tb_ + r; \
                const int row = tt < 0 ? (MR + NMETA + tt) : (tt < SEQL ? b * SEQL + tt : b * SEQL + SEQL - 1); \
                dst[r] = *(const unsigned*)(U + (size_t)row * 1024 + ch); } } while (0)
        CONV_LOAD(0, raw[0], acc[0]); CONV_LOAD(1, raw[1], acc[0]);
#pragma unroll
        for (int g = 0; g < 8; ++g) {
            if (g + 2 < 8) { const int og = (8 * g - 8) < 0 ? 0 : ((8 * g - 8) > 31 ? 31 : (8 * g - 8)); CONV_LOAD(g + 2, raw[(g + 2) % 3], acc[og]); }
#pragma unroll
            for (int r = 0; r < 8; ++r) { const int ii = 8 * g + r; if (ii < 62) {
                const unsigned rw = raw[g % 3][r];
                f32x2 uv = {__uint_as_float(rw << 16), __uint_as_float(rw & 0xffff0000u)};
                if (t0 - 15 + ii >= SEQL) uv = (f32x2){0.f, 0.f};
#pragma unroll
                for (int o = 0; o < 32; ++o) { const int j = ii - o; if (j >= 0 && j <= 30) acc[o] += w[j] * uv; } } }
        }
#undef CONV_LOAD
#pragma unroll
        for (int o = 0; o < 32; ++o) *(LAS f32x2*)(tile + o * 1024 + ch) = acc[o];
        __syncthreads();
        {
            const size_t grow0 = (size_t)(b * SEQL + t0 + wave * 4) * 1024, crow0 = grow0 * 2;
            v2u zz[4][4];
#pragma unroll
            for (int k = 0; k < 4; ++k)
#pragma unroll
                for (int j = 0; j < 4; ++j) zz[k][j] = *(const v2u*)(SZ + grow0 + (size_t)k * 1024 + 4 * lane + 256 * j);
            f32x4 v[4][4]; float s[4];
#pragma unroll
            for (int k = 0; k < 4; ++k) { const LAS float* rp = tile + (wave * 4 + k) * 1024 + 4 * lane; s[k] = 0.f;
#pragma unroll
                for (int j = 0; j < 4; ++j) { v[k][j] = *(const LAS f32x4*)(rp + 256 * j); s[k] += (v[k][j].x + v[k][j].y) + (v[k][j].z + v[k][j].w); } }
#pragma unroll
            for (int o = 1; o < 64; o <<= 1)
#pragma unroll
                for (int k = 0; k < 4; ++k) s[k] += shx(s[k], o, lane);
            float s2[4];
#pragma unroll
            for (int k = 0; k < 4; ++k) { const float mean = s[k] * (1.f / 1024.f); s2[k] = 0.f;
#pragma unroll
                for (int j = 0; j < 4; ++j) { v[k][j] = v[k][j] - mean; s2[k] += (v[k][j].x * v[k][j].x + v[k][j].y * v[k][j].y) + (v[k][j].z * v[k][j].z + v[k][j].w * v[k][j].w); } }
#pragma unroll
            for (int o = 1; o < 64; o <<= 1)
#pragma unroll
                for (int k = 0; k < 4; ++k) s2[k] += shx(s2[k], o, lane);
#pragma unroll
            for (int j = 0; j < 4; ++j) { const int col = 4 * lane + 256 * j; const f32x4 g4 = *(const f32x4*)(cn_g + col), b4 = *(const f32x4*)(cn_b + col);
#pragma unroll
                for (int k = 0; k < 4; ++k) { const float rstd = 1.f / sqrtf(s2[k] * (1.f / 1024.f) + 1e-6f);
                    f32x4 y = v[k][j] * rstd * g4 + b4;
                    y = y * pg8::sigm4(y); y = y * pg8::bf_lo4(zz[k][j].x, zz[k][j].y);
                    v2u o; o.x = pk2(y.x, y.y); o.y = pk2(y.z, y.w); __builtin_nontemporal_store(o, (v2u*)(C + crow0 + (size_t)k * 2048 + col)); } }
        }
        __syncthreads();
    }
}

__device__ __forceinline__ void meta_proj(unsigned char* ws, const float* kg, LAS unsigned char* lds, int item, int wave, int lane) {
    typedef short bf16x8_t __attribute__((ext_vector_type(8)));
    const bf16* XN = (const bf16*)(ws + WS_XN); const bf16* WIN = (const bf16*)(ws + WS_WIN);
    bf16* U = (bf16*)(ws + WS_U); bf16* Kb = (bf16*)(ws + WS_K); bf16* Vb = (bf16*)(ws + WS_V);
    const int col = lane & 15, quad = lane >> 4;
    int nb[4]; int nblk;
    if (item < 64) { const int ch0 = 16 * item, pn = ch0 >> 7, j0 = ch0 & 127; nblk = 2; nb[0] = 256 * pn + j0; nb[1] = nb[0] + 128; nb[2] = nb[0]; nb[3] = nb[1]; }
    else if (item < 68) { const int hd = item - 64; nblk = 4; nb[0] = 4096 + 32 * hd; nb[1] = nb[0] + 16; nb[2] = nb[0] + 128; nb[3] = nb[2] + 16; }
    else { const int it = item - 68; nblk = 4; nb[0] = 4352 + 64 * it; nb[1] = nb[0] + 16; nb[2] = nb[0] + 32; nb[3] = nb[0] + 48; }
    f32x4 acc[4];
#pragma unroll
    for (int k = 0; k < 4; ++k) acc[k] = (f32x4){0.f, 0.f, 0.f, 0.f};
    const bf16* ap = XN + (size_t)(MR + col) * 1024 + 128 * wave + 8 * quad;
#pragma unroll
    for (int q = 0; q < 4; ++q) {
        const bf16x8_t av = *(const bf16x8_t*)(ap + 32 * q);
#pragma unroll
        for (int k = 0; k < 4; ++k) if (k < nblk) {
            const bf16x8_t bv = *(const bf16x8_t*)(WIN + (size_t)(nb[k] + col) * 1024 + 128 * wave + 32 * q + 8 * quad);
            acc[k] = __builtin_amdgcn_mfma_f32_16x16x32_bf16(av, bv, acc[k], 0, 0, 0); }
    }
    LAS f32x4* red = (LAS f32x4*)lds;
#pragma unroll
    for (int k = 0; k < 4; ++k) red[(wave * 4 + k) * 64 + lane] = acc[k];
    __syncthreads();
    if (wave == 0) {
#pragma unroll
        for (int k = 0; k < 4; ++k) { f32x4 s = red[k * 64 + lane];
#pragma unroll
            for (int w = 1; w < 8; ++w) s = s + red[(w * 4 + k) * 64 + lane];
            acc[k] = s; }
        if (item < 64) {
#pragma unroll
            for (int r = 0; r < 4; ++r) { const float u = acc[0][r] * pg8::sigm_f(acc[1][r]); U[(size_t)(MR + 4 * quad + r) * 1024 + 16 * item + col] = (bf16)(pk2(u, 0.f) & 0xffffu); }
        } else if (item < 68) {
            const int hd = item - 64;
#pragma unroll
            for (int r = 0; r < 4; ++r) { float ss = 0.f;
#pragma unroll
                for (int k = 0; k < 4; ++k) ss += acc[k][r] * acc[k][r];
                ss += shx(ss, 1, lane); ss += shx(ss, 2, lane); ss += shx(ss, 4, lane); ss += shx(ss, 8, lane);
                const float rstd = 1.0f / sqrtf(ss * (1.0f / 64.0f) + 1e-6f);
#pragma unroll
                for (int k = 0; k < 4; ++k) { const int bj = k >> 1, i32 = 16 * (k & 1) + col, dn = 32 * bj + 16 * ((i32 >> 2) & 1) + 4 * (i32 >> 3) + (i32 & 3);
                    const float v = acc[k][r] * rstd * kg[dn]; Kb[(size_t)(MR + 4 * quad + r) * 256 + hd * 64 + 32 * bj + i32] = (bf16)(pk2(v, 0.f) & 0xffffu); } }
        } else {
            const int it = item - 68;
#pragma unroll
            for (int r = 0; r < 4; ++r)
#pragma unroll
                for (int k = 0; k < 4; ++k) Vb[(size_t)(MR + 4 * quad + r) * 256 + 64 * it + 16 * k + col] = (bf16)(pk2(acc[k][r], 0.f) & 0xffffu);
        }
    }
    __syncthreads();
}

__global__ void __launch_bounds__(NWAVES * 64, 2) fwd_kernel(Args a) {
    extern __shared__ __attribute__((aligned(16))) unsigned char lds[];
    cg::grid_group grid = cg::this_grid();
    LAS unsigned char* l3 = (LAS unsigned char*)lds;
    const int wave = __builtin_amdgcn_readfirstlane(threadIdx.x >> 6);
#define GRID_SEAM() do { const bool t0_ = (wave == 0) && (LANE_ID() == 0); XcdBarrier xb_; xb_.bar = (unsigned*)(a.ws + WS_CTL) + CW_BAR; xb_.x = xb_xcc_id(); xb_.st = (volatile LAS unsigned*)(l3 + MISC_OFF) + 8; xcd_barrier(xb_, t0_); } while (0)
#define OPAQUE_WS() do { size_t z_ = 0; asm volatile("" : "+s"(z_)); ws = a.ws + z_; } while (0)
    const int G = gridDim.x, bx = blockIdx.x, vcu = (G % 8 == 0) ? (bx % 8) * (G / 8) + bx / 8 : bx;
    unsigned char* ws;
#define XN ((bf16*)(ws + WS_XN))
#define Ub ((bf16*)(ws + WS_U))
#define SZb ((bf16*)(ws + WS_SZ))
#define Qb ((bf16*)(ws + WS_Q))
#define SAZb ((bf16*)(ws + WS_SAZ))
#define GCSb ((bf16*)(ws + WS_GCS))
#define GASb ((bf16*)(ws + WS_GAS))
#define Kb ((bf16*)(ws + WS_K))
#define Vb ((bf16*)(ws + WS_V))
    for (int u = wave * 64 + LANE_ID(); u < (LDS_BYTES - LDSCTL_OFF) / 4; u += NWAVES * 64) ((LAS unsigned*)(l3 + LDSCTL_OFF))[u] = 0u;
    __syncthreads();
    (void)xcd_barrier_post((unsigned*)(a.ws + WS_CTL) + CW_BAR, (volatile LAS unsigned*)(l3 + MISC_OFF) + 8, (wave == 0) && (LANE_ID() == 0));
    if (a.ph_hi == 0x7fffffff) grid.sync();
#ifndef MK_REP_SYNC
#define MK_REP_SYNC 0
#endif
#define REP_SYNC() do { if (MK_REP_SYNC && rep_ > 0) GRID_SEAM(); } while (0)
#ifndef MK_REP_ATTN
#define MK_REP_ATTN 1
#endif
#ifndef MK_REP_SEAM
#define MK_REP_SEAM 1
#endif
#ifndef MK_REP_P0
#define MK_REP_P0 1
#endif
#ifndef MK_REP_P1
#define MK_REP_P1 1
#endif
#ifndef MK_REP_CONV
#define MK_REP_CONV 1
#endif
#ifndef MK_REP_P345
#define MK_REP_P345 1
#endif
#define IN(k) (a.ph_lo <= (k) && (k) < a.ph_hi)
#define SEAM(k) do { if (IN(k) && IN((k) + 1)) for (int rs_ = 0; rs_ < MK_REP_SEAM; ++rs_) GRID_SEAM(); OPAQUE_WS(); } while (0)
    OPAQUE_WS();
    if (IN(0)) for (int rep_ = 0; rep_ < MK_REP_P0; ++rep_) { const int lane = LANE_ID(), tid = wave * 64 + lane; p0_prologue(a, l3, vcu, G, tid, lane, wave); __syncthreads(); }
    SEAM(0);
    if (IN(1)) for (int rep_ = 0; rep_ < MK_REP_P1; ++rep_) { REP_SYNC();
        for (int item = bx; item < 72; item += G) { int lane = LANE_ID(); asm volatile("" : "+v"(lane)); meta_proj(ws, a.k_g, l3, item, wave, lane); }
        {
            pg8::Gemm g{XN, (const bf16*)(ws + WS_WIN), MR, 16 * 256, DMODEL, DMODEL}; pg8::RemapOrder S; S.base.init(MR, 16 * 256, G, bx); S.mode = 0;
            pg8::EpiIn<0> E{ws, a.q_g, a.k_g, WS_U, WS_SZ, WS_Q, WS_K, WS_V, WS_SAZ, WS_GCS, WS_GAS, WS_ROPE};
            pg8::gemm_phase<pg8::EpiIn<0>, pg8::RemapOrder, PG8_ALIGN, PG8_SP2, false>(l3, g, S, E, wave);
        }
        {
            pg8::Gemm g{(const bf16*)((const unsigned char*)a.out + OUT_XN8), (const bf16*)((const unsigned char*)a.out + OUT_W8), MR, 14 * 256, DMODEL / 2, DMODEL / 2}; pg8::RemapOrder S; S.base.init(MR, 14 * 256, G, bx); S.mode = 1;
            pg8::EpiIn<1> E{ws, a.q_g, a.k_g, WS_U, WS_SZ, WS_Q, WS_K, WS_V, WS_SAZ, WS_GCS, WS_GAS, WS_ROPE};
            pg8::gemm_phase<pg8::EpiIn<1>, pg8::RemapOrder, PG8_ALIGN, PG8_SP2, true>(l3, g, S, E, wave);
        }
    }
    SEAM(1);
    if (IN(2)) {
        const int ksplit = (vcu & 3) == 0 ? 0 : (vcu & 3) == 1 ? 3 : (vcu & 3) == 2 ? 5 : 8;
#pragma unroll 1
        for (int s_ = 0; s_ < 3; ++s_) {
            if (s_ == 1) { int lane = LANE_ID(); asm volatile("" : "+v"(lane)); const int tid = wave * 64 + lane; conv_phase(ws, a, l3, vcu, G, tid, lane, wave); }
            else {
                const attn_body::AttnTensors AT{(const attn_body::bf16*)Qb, (const attn_body::bf16*)Kb, (const attn_body::bf16*)Vb, (attn_body::bf16*)a.out + DMODEL, (const attn_body::bf16*)SAZb};
                attn_body::attn_phase<8>((char*)lds, AT, vcu, G, wave, s_ == 0 ? 0 : ksplit, s_ == 0 ? ksplit : 8);
            }
        }
    }
    SEAM(2);
    if (IN(3)) for (int rep_ = 0; rep_ < MK_REP_P345; ++rep_) { REP_SYNC();
        pg8::Gemm g{(const bf16*)a.out, (const bf16*)(ws + WS_WC), MR, DMODEL, DMODEL, 2 * DMODEL}; pg8::TwoPassOrder S; S.base.init(MR, DMODEL, G, bx); S.K = DMODEL;
        pg8::EpiMerge E{SZb, GCSb, GASb};
        pg8::gemm_phase<pg8::EpiMerge, pg8::TwoPassOrder, PG8_ALIGN, PG8_SP2>(l3, g, S, E, wave);
    }
    SEAM(3);
    if (IN(4)) for (int rep_ = 0; rep_ < MK_REP_P345; ++rep_) { REP_SYNC();
        pg8::Gemm g{SZb, (const bf16*)(ws + WS_WO), MR, DMODEL, DMODEL, DMODEL}; pg8::StaticOrder S; S.init(MR, DMODEL, G, bx);
        pg8::EpiOut E{a.x, a.out};
        pg8::gemm_phase<pg8::EpiOut, pg8::StaticOrder, PG8_ALIGN, PG8_SP2>(l3, g, S, E, wave);
    }
}

#ifdef MK_DIAG
__global__ void dump_k(const unsigned short* A, const unsigned short* B, float wa, float wb, float* o, int n) {
    int i = blockIdx.x * blockDim.x + threadIdx.x; if (i < n) o[i] = wa * __uint_as_float((unsigned)A[i] << 16) + wb * __uint_as_float((unsigned)B[i] << 16); }
#endif
extern "C" void kernel_launch(void* const* d_in, const int* in_sizes, int n_in, void* d_out, int out_size, void* d_ws, size_t ws_size, hipStream_t stream) {
    static int grid = 0;
    if (grid == 0) {
        if (n_in != 13 || out_size != MR * DMODEL || ws_size < WS_END) { fprintf(stderr, "kernel_launch: unexpected shapes (n_in %d, out %d, ws %zu)\n", n_in, out_size, ws_size); grid = -1; return; }
        int dev = 0, cus = 0, per_cu = 0;
        if (hipGetDevice(&dev) != hipSuccess || hipDeviceGetAttribute(&cus, hipDeviceAttributeMultiprocessorCount, dev) != hipSuccess) { grid = -1; return; }
        if (hipFuncSetAttribute((const void*)fwd_kernel, hipFuncAttributeMaxDynamicSharedMemorySize, LDS_BYTES) != hipSuccess) { fprintf(stderr, "kernel_launch: hipFuncSetAttribute failed\n"); grid = -1; return; }
        if (hipOccupancyMaxActiveBlocksPerMultiprocessor(&per_cu, (const void*)fwd_kernel, NWAVES * 64, LDS_BYTES) != hipSuccess || per_cu < 1) { fprintf(stderr, "kernel_launch: occupancy query says %d\n", per_cu); per_cu = 1; }
        (void)hipGetLastError();
        grid = cus;
    }
    if (grid < 0) return;
    Args a{};
    a.x = (const float*)d_in[0]; a.meta = (const float*)d_in[1]; a.norm_g = (const float*)d_in[2]; a.w_in = (const float*)d_in[3]; a.conv_w = (const float*)d_in[4]; a.conv_b = (const float*)d_in[5];
    a.cn_g = (const float*)d_in[6]; a.cn_b = (const float*)d_in[7]; a.w_conv_out = (const float*)d_in[8]; a.q_g = (const float*)d_in[9]; a.k_g = (const float*)d_in[10]; a.w_attn_out = (const float*)d_in[11];
    a.w_out = (const float*)d_in[12]; a.out = (float*)d_out; a.ws = (unsigned char*)d_ws;
#ifndef MK_N_LAUNCHES
#define MK_N_LAUNCHES 1
#endif
#ifdef MK_DIAG
    for (int li = 0; li < MK_DIAG; ++li) {
        a.ph_lo = li; a.ph_hi = li + 1; void* args[] = {&a};
        (void)hipLaunchCooperativeKernel((const void*)fwd_kernel, dim3(grid), dim3(NWAVES * 64), args, LDS_BYTES, stream);
    }
    dump_k<<<MR * DMODEL / 256, 256, 0, stream>>>((const unsigned short*)((char*)d_ws + MK_DIAG_A), (const unsigned short*)((char*)d_ws + MK_DIAG_B), MK_DIAG_WA, MK_DIAG_WB, (float*)d_out, MR * DMODEL);
    return;
#endif
    if (hipMemsetAsync((char*)d_ws + WS_CTL, 0, CTL_ZERO_BYTES, stream) != hipSuccess) { fprintf(stderr, "kernel_launch: hipMemsetAsync failed\n"); return; }
    for (int li = 0; li < MK_N_LAUNCHES; ++li) {
        a.ph_lo = (MK_N_LAUNCHES == 1) ? 0 : li; a.ph_hi = (MK_N_LAUNCHES == 1) ? 5 : li + 1;
        void* args[] = {&a};
        const hipError_t e = hipLaunchCooperativeKernel((const void*)fwd_kernel, dim3(grid), dim3(NWAVES * 64), args, LDS_BYTES, stream);
        if (e != hipSuccess) fprintf(stderr, "kernel_launch: cooperative launch failed: %s (grid %d)\n", hipGetErrorString(e), grid);
    }
}
```
